# Optimizing an MI355X kernel written in HIP

```python
import math
import jax, jax.numpy as jnp
from jax import lax
import numpy as np

D_MODEL = 2048
BATCH = 4
SEQ = 2048
DEPTH = 2

CHUNK = 64
N_PREV_CHUNKS = 8
BAND = (N_PREV_CHUNKS + 1) * CHUNK
ATT_HEADS = 8
ATT_HEAD_DIM = D_MODEL // 16
ATT_WIDTH = ATT_HEADS * ATT_HEAD_DIM
REL_CLIP = 128
N_REL = 2 * REL_CLIP + 1
SGU_GROUPS = 8
SGU_GROUP_DIM = D_MODEL // 16
SGU_WIDTH = SGU_GROUPS * SGU_GROUP_DIM
SGU_WINDOW = 128
MIX_WIDTH = ATT_WIDTH + SGU_WIDTH
IN_WIDTH = 3 * ATT_WIDTH + 2 * SGU_WIDTH
N_EXPERTS = 16
N_EXPERT_GROUPS = 4
EXPERTS_PER_GROUP = N_EXPERTS // N_EXPERT_GROUPS
TOP_K = 2
D_FF_EXPERT = D_MODEL // 2
DEEPNORM_ALPHA = (2.0 * DEPTH) ** 0.25
DEEPNORM_BETA = (8.0 * DEPTH) ** -0.25
LN_EPS = 1e-5
NEG_INF = -1e30

kernel_name = "chunk_hybrid_relattn_sgu_grouped_moe_deepnorm"


def layer_norm(x, g, b):
    xf = x.astype(jnp.float32)
    mu = jnp.mean(xf, axis=-1, keepdims=True)
    xc = xf - mu
    var = jnp.mean(jnp.square(xc), axis=-1, keepdims=True)
    y = xc * lax.rsqrt(var + LN_EPS) * g.astype(jnp.float32) + b.astype(jnp.float32)
    return y.astype(x.dtype)


def _rel_index():
    i = np.arange(CHUNK)[:, None]
    key_pos = np.arange(BAND)[None, :] - N_PREV_CHUNKS * CHUNK
    return np.clip(i - key_pos, -REL_CLIP, REL_CLIP) + REL_CLIP


def _band_valid(n_chunks):
    j = np.arange(BAND) // CHUNK
    return (np.arange(n_chunks)[:, None] - N_PREV_CHUNKS + j[None, :]) >= 0


def chunk_band_attention(q, k, v, rel_table):
    b, s, h, dh = q.shape
    nc = s // CHUNK
    qc = q.reshape(b, nc, CHUNK, h, dh)

    def band(t):
        tc = t.reshape(b, nc, CHUNK, h, dh)
        tp = jnp.pad(tc, ((0, 0), (N_PREV_CHUNKS, 0), (0, 0), (0, 0), (0, 0)))
        return jnp.concatenate([tp[:, j:j + nc] for j in range(N_PREV_CHUNKS + 1)], axis=2)

    kb, vb = band(k), band(v)
    scores = jnp.einsum('bnqhd,bnkhd->bnhqk', qc.astype(jnp.float32), kb.astype(jnp.float32))
    scores = scores * (1.0 / math.sqrt(dh))
    bias = rel_table.astype(jnp.float32)[:, _rel_index()]
    scores = scores + bias[None, None]
    valid = jnp.asarray(_band_valid(nc))[None, :, None, None, :]
    scores = jnp.where(valid, scores, NEG_INF)
    p = jax.nn.softmax(scores, axis=-1).astype(v.dtype)
    out = jnp.einsum('bnhqk,bnkhd->bnqhd', p, vb)
    return out.reshape(b, s, h * dh)


def spatial_gating(u, v, ln_g, ln_b, w_s, b_s):
    b, s, _ = u.shape
    nb = s // SGU_WINDOW
    v = layer_norm(v, ln_g, ln_b)
    vb = v.reshape(b, nb, SGU_WINDOW, SGU_GROUPS, SGU_GROUP_DIM)
    causal = jnp.asarray(np.tril(np.ones((SGU_WINDOW, SGU_WINDOW), dtype=bool)))
    w_m = jnp.where(causal[None], w_s, jnp.zeros((), w_s.dtype))
    mixed = jnp.einsum('gts,bnsgc->bntgc', w_m, vb) + b_s.T[None, None, :, :, None]
    return u * mixed.reshape(b, s, SGU_WIDTH)


def grouped_top2_moe(h, router_w, router_b, w_gate, w_up, w_down):
    b, s, d = h.shape
    t = h.reshape(b * s, d)
    logits = t.astype(jnp.float32) @ router_w.astype(jnp.float32) + router_b.astype(jnp.float32)
    probs = jax.nn.softmax(logits, axis=-1)
    pg = probs.reshape(-1, N_EXPERT_GROUPS, EXPERTS_PER_GROUP)
    group_score = lax.top_k(pg, TOP_K)[0].sum(-1)
    sel_group = jnp.argmax(group_score, axis=-1)
    in_group = (jnp.arange(N_EXPERT_GROUPS)[None, :] == sel_group[:, None])[:, :, None]
    masked = jnp.where(in_group, pg, -1.0).reshape(-1, N_EXPERTS)
    top_p, top_i = lax.top_k(masked, TOP_K)
    gates = top_p / jnp.sum(top_p, axis=-1, keepdims=True)
    combine = jnp.sum(jax.nn.one_hot(top_i, N_EXPERTS, dtype=jnp.float32) * gates[..., None], axis=1)
    out = jnp.zeros((b * s, d), jnp.float32)
    for e in range(N_EXPERTS):
        hid = jax.nn.silu(t @ w_gate[e]) * (t @ w_up[e])
        out = out + combine[:, e:e + 1] * (hid @ w_down[e]).astype(jnp.float32)
    return out.astype(h.dtype).reshape(b, s, d)


def setup_inputs(seed: int = 0) -> dict:
    key = jax.random.key(seed)
    ks = jax.random.split(key, 20)
    f32 = jnp.float32
    L = DEPTH
    col_scale = jnp.concatenate([
        jnp.ones((2 * ATT_WIDTH,), f32),
        jnp.full((ATT_WIDTH + 2 * SGU_WIDTH,), DEEPNORM_BETA, f32)])
    x = jax.random.normal(ks[0], (BATCH, SEQ, D_MODEL), f32)
    ln_in_g = 1.0 + 0.02 * jax.random.normal(ks[1], (D_MODEL,), f32)
    ln_in_b = 0.02 * jax.random.normal(ks[2], (D_MODEL,), f32)
    w_in = jax.random.normal(ks[3], (L, D_MODEL, IN_WIDTH), f32) * (D_MODEL ** -0.5) * col_scale
    rel_bias = 0.1 * jax.random.normal(ks[4], (L, ATT_HEADS, N_REL), f32)
    sgu_ln_g = 1.0 + 0.02 * jax.random.normal(ks[5], (L, SGU_WIDTH), f32)
    sgu_ln_b = 0.02 * jax.random.normal(ks[6], (L, SGU_WIDTH), f32)
    sgu_w = jax.random.normal(ks[7], (L, SGU_GROUPS, SGU_WINDOW, SGU_WINDOW), f32) * (0.5 * SGU_WINDOW ** -0.5)
    sgu_b = 1.0 + 0.02 * jax.random.normal(ks[8], (L, SGU_GROUPS, SGU_WINDOW), f32)
    w_out = jax.random.normal(ks[9], (L, MIX_WIDTH, D_MODEL), f32) * (DEEPNORM_BETA * MIX_WIDTH ** -0.5)
    ln1_g = 1.0 + 0.02 * jax.random.normal(ks[10], (L, D_MODEL), f32)
    ln1_b = 0.02 * jax.random.normal(ks[11], (L, D_MODEL), f32)
    router_w = jax.random.normal(ks[12], (D_MODEL, N_EXPERTS), f32) * (D_MODEL ** -0.5)
    router_b = 0.01 * jax.random.normal(ks[13], (N_EXPERTS,), f32)
    w_gate = jax.random.normal(ks[14], (L, N_EXPERTS, D_MODEL, D_FF_EXPERT), f32) * (DEEPNORM_BETA * D_MODEL ** -0.5)
    w_up = jax.random.normal(ks[15], (L, N_EXPERTS, D_MODEL, D_FF_EXPERT), f32) * (DEEPNORM_BETA * D_MODEL ** -0.5)
    w_down = jax.random.normal(ks[16], (L, N_EXPERTS, D_FF_EXPERT, D_MODEL), f32) * (DEEPNORM_BETA * D_FF_EXPERT ** -0.5)
    ln2_g = 1.0 + 0.02 * jax.random.normal(ks[17], (L, D_MODEL), f32)
    ln2_b = 0.02 * jax.random.normal(ks[18], (L, D_MODEL), f32)
    return {"x": x, "ln_in_g": ln_in_g, "ln_in_b": ln_in_b, "w_in": w_in, "rel_bias": rel_bias,
            "sgu_ln_g": sgu_ln_g, "sgu_ln_b": sgu_ln_b, "sgu_w": sgu_w, "sgu_b": sgu_b,
            "w_out": w_out, "ln1_g": ln1_g, "ln1_b": ln1_b, "router_w": router_w,
            "router_b": router_b, "w_gate": w_gate, "w_up": w_up, "w_down": w_down,
            "ln2_g": ln2_g, "ln2_b": ln2_b}


def reference(x, ln_in_g, ln_in_b, w_in, rel_bias, sgu_ln_g, sgu_ln_b, sgu_w, sgu_b,
              w_out, ln1_g, ln1_b, router_w, router_b, w_gate, w_up, w_down, ln2_g, ln2_b):
    b, s, _ = x.shape
    h = layer_norm(x, ln_in_g, ln_in_b)
    splits = [ATT_WIDTH, 2 * ATT_WIDTH, 3 * ATT_WIDTH, 3 * ATT_WIDTH + SGU_WIDTH]
    for l in range(DEPTH):
        z = h @ w_in[l]
        q, k, v, u_s, v_s = jnp.split(z, splits, axis=-1)
        hd = (b, s, ATT_HEADS, ATT_HEAD_DIM)
        y_att = chunk_band_attention(q.reshape(hd), k.reshape(hd), v.reshape(hd), rel_bias[l])
        y_sgu = spatial_gating(jax.nn.gelu(u_s, approximate=False), jax.nn.gelu(v_s, approximate=False),
                               sgu_ln_g[l], sgu_ln_b[l], sgu_w[l], sgu_b[l])
        mix = jnp.concatenate([y_att, y_sgu], axis=-1) @ w_out[l]
        h = layer_norm(DEEPNORM_ALPHA * h + mix, ln1_g[l], ln1_b[l])
        ffn = grouped_top2_moe(h, router_w, router_b, w_gate[l], w_up[l], w_down[l])
        h = layer_norm(DEEPNORM_ALPHA * h + ffn, ln2_g[l], ln2_b[l])
    return h
```

```cpp
#include <hip/hip_runtime.h>
#include <cstdio>

#define LAS __attribute__((address_space(3)))
#define GAS __attribute__((address_space(1)))
typedef unsigned short bf16_t;
typedef short bf16x8 __attribute__((ext_vector_type(8)));
typedef short s16x4 __attribute__((ext_vector_type(4)));
typedef float f32x2 __attribute__((ext_vector_type(2)));
typedef float f32x4 __attribute__((ext_vector_type(4)));
typedef float f32x16 __attribute__((ext_vector_type(16)));
typedef unsigned u32x2 __attribute__((ext_vector_type(2)));
typedef unsigned u32x4 __attribute__((ext_vector_type(4)));
typedef int v8i __attribute__((ext_vector_type(8)));
template <bool Q8> struct Frag;
template <> struct Frag<false> { bf16x8 k[2]; };
template <> struct Frag<true> { v8i q; };
typedef unsigned char fp8_t;

constexpr int M = 8192, D = 2048, SEQ = 2048, NBATCH = 4, DEPTH = 2;
constexpr int AW = 1024, NH = 8, HD = 128, SW = 1024, NG = 8, NIN = 5120, FF = 1024, NE = 16;
constexpr int NREL = 257;
constexpr float LN_EPS = 1e-5f;
constexpr float ALPHA = 1.4142135623730951f;
constexpr float LOG2E = 1.4426950408889634f;
constexpr float QSCALE = 0.08838834764831845f * LOG2E;
constexpr int MPAD = 20480;

constexpr size_t MiB = 1u << 20;
constexpr size_t WS_CTL = 0, CTL_ZERO_BYTES = 1 * MiB;
constexpr size_t WS_WIN = 1 * MiB;
constexpr size_t WS_WOUT = 41 * MiB;
constexpr size_t WS_WGU = 57 * MiB;
constexpr size_t WS_WD = 313 * MiB;
constexpr size_t WS_HB = 441 * MiB;
constexpr size_t WS_Q = 473 * MiB;
constexpr size_t WS_YCAT = 553 * MiB;
constexpr size_t WS_STAT = 585 * MiB;
constexpr size_t WS_ROUTE = 586 * MiB;
constexpr size_t WS_HID = 588 * MiB;
constexpr size_t WS_Y = 628 * MiB;
constexpr size_t WS_HQ = 708 * MiB;
constexpr size_t WS_END = 724 * MiB;
constexpr int CW_BAR = 4096, CW_CNT = 16384;

constexpr int RING_BYTES = 131072;
constexpr int LC_OFF = RING_BYTES;
constexpr int LC_XB = 0, LC_LCNT = 64, LC_LBASE = 128, LC_ECNT = 192, LC_TSTART = 256, LC_ROWINFO = 512, LC_SGUST = 2048, LC_PARK = 4096;
constexpr int LDS_BYTES = 147456;

__device__ __forceinline__ unsigned cvt_pk_bf16(float lo, float hi) { unsigned r; asm volatile("v_cvt_pk_bf16_f32 %0, %1, %2" : "=v"(r) : "v"(lo), "v"(hi)); return r; }
__device__ __forceinline__ unsigned pk4_fp8(float a, float b, float c, float d) { int w = 0; w = __builtin_amdgcn_cvt_pk_fp8_f32(a, b, w, false); w = __builtin_amdgcn_cvt_pk_fp8_f32(c, d, w, true); return (unsigned)w; }
__device__ __forceinline__ fp8_t f2fp8(float x) { return (fp8_t)(__builtin_amdgcn_cvt_pk_fp8_f32(x, x, 0, false) & 0xff); }
constexpr float SC_Y = 16.0f;
constexpr float SC_W = 128.0f;
__device__ __forceinline__ float bf2f(unsigned short x) { return __uint_as_float(((unsigned)x) << 16); }
__device__ __forceinline__ f32x4 bf4_to_f32(u32x2 w) { return (f32x4){__uint_as_float(w.x << 16), __uint_as_float(w.x & 0xffff0000u), __uint_as_float(w.y << 16), __uint_as_float(w.y & 0xffff0000u)}; }
__device__ __forceinline__ float wave_sum(float v) {
#pragma unroll
    for (int o = 1; o < 64; o <<= 1) v += __shfl_xor(v, o);
    return v;
}
__device__ __forceinline__ int lane_id() { int l_; asm volatile("v_mbcnt_lo_u32_b32 %0, -1, 0\n\tv_mbcnt_hi_u32_b32 %0, -1, %0" : "=v"(l_)); return l_; }
#define TIDX(wv) ((wv) * 64 + lane_id())
#define LDS_WAIT() asm volatile("s_waitcnt lgkmcnt(0)" ::: "memory")
#define VM_WAIT() asm volatile("s_waitcnt vmcnt(0)" ::: "memory")
#define SBAR() __builtin_amdgcn_sched_barrier(0)

#define XB_TMO      128
#define XB_XCNT(j)  (256  + 64 * (j))
#define XB_XSUB(j)  (1280 + 64 * (j))
#define XB_XGEN(j)  (2304 + 64 * (j))
#define XB_TOP      3328
#define XB_TOPGEN   3392
#define XCD_BAR_WORDS 3456
#define XB_SPIN_CAP (1u << 18)
__device__ __forceinline__ unsigned xb_ld(unsigned* p)              { return __hip_atomic_load(p, __ATOMIC_RELAXED, __HIP_MEMORY_SCOPE_AGENT); }
__device__ __forceinline__ unsigned xb_add(unsigned* p, unsigned v) { return __hip_atomic_fetch_add(p, v, __ATOMIC_RELAXED, __HIP_MEMORY_SCOPE_AGENT); }
__device__ __forceinline__ unsigned xb_xcc_id() { return (unsigned)__builtin_amdgcn_s_getreg((3 << 11) | 20) & 0xFu; }
#define XB_SPIN(cond, bar) do { unsigned _sp = 0; while (cond) { __builtin_amdgcn_s_sleep(1); \
    if ((++_sp & 255u) == 0u) { if (xb_ld(&(bar)[XB_TMO])) break; if (_sp > XB_SPIN_CAP) { atomicAdd(&(bar)[XB_TMO], 1u); break; } } } } while (0)
struct XcdBarrier { unsigned* bar; unsigned x; volatile LAS unsigned* st; int wv; };
__device__ __forceinline__ XcdBarrier xcd_barrier_post(unsigned* bar, volatile LAS unsigned* st, int wv) {
    XcdBarrier b; b.bar = bar; b.x = xb_xcc_id(); b.st = st; b.wv = wv;
    if (TIDX(wv) == 0) (void)xb_add(&bar[XB_XCNT(b.x)], 1u);
    return b;
}
__device__ __forceinline__ void xcd_barrier_complete(unsigned* bar, unsigned x, unsigned& nloc, unsigned& nx) {
    const unsigned G = gridDim.x * gridDim.y * gridDim.z;
    unsigned sum, cnt, mine, sp = 0u;
    for (;;) {
        sum = 0u; cnt = 0u; mine = 0u;
#pragma unroll
        for (unsigned j = 0; j < 16; ++j) { const unsigned c = xb_ld(&bar[XB_XCNT(j)]); sum += c; cnt += (c > 0u) ? 1u : 0u; mine = (j == x) ? c : mine; }
        if (sum == G) break;
        __builtin_amdgcn_s_sleep(1);
        if ((++sp & 255u) == 0u) { if (xb_ld(&bar[XB_TMO])) break; if (sp > XB_SPIN_CAP) { atomicAdd(&bar[XB_TMO], 1u); break; } }
    }
    nloc = mine > 0u ? mine : 1u; nx = cnt > 0u ? cnt : 1u;
}
__device__ __forceinline__ void xcd_barrier(const XcdBarrier& b) {
    asm volatile("s_waitcnt vmcnt(0)" ::: "memory");
    __syncthreads();
    if (TIDX(b.wv) == 0) {
        unsigned* bar = b.bar; const unsigned bx_ = xb_xcc_id();
        __builtin_amdgcn_s_waitcnt(0);
        unsigned nloc = b.st[0], nx = b.st[1];
        if (nloc == 0u) { xcd_barrier_complete(bar, bx_, nloc, nx); b.st[0] = nloc; b.st[1] = nx; }
        const unsigned old = xb_add(&bar[XB_XSUB(bx_)], 1u);
        const unsigned gen = old / nloc;
        if (old + 1u == (gen + 1u) * nloc) {
            __builtin_amdgcn_fence(__ATOMIC_RELEASE, "agent");
            asm volatile("s_waitcnt vmcnt(0)" ::: "memory");
            const unsigned og = xb_add(&bar[XB_TOP], 1u);
            const unsigned tg = og / nx;
            if (og + 1u == (tg + 1u) * nx) xb_add(&bar[XB_TOPGEN], 1u);
            else XB_SPIN(xb_ld(&bar[XB_TOPGEN]) == tg, bar);
            __builtin_amdgcn_fence(__ATOMIC_ACQUIRE, "agent");
            xb_add(&bar[XB_XGEN(bx_)], 1u);
            asm volatile("s_waitcnt vmcnt(0)" ::: "memory");
        } else {
            XB_SPIN(xb_ld(&bar[XB_XGEN(bx_)]) == gen, bar);
            __builtin_amdgcn_fence(__ATOMIC_ACQUIRE, "agent");
            asm volatile("s_waitcnt vmcnt(0)" ::: "memory");
        }
    }
    __syncthreads();
}

namespace pg8 {
constexpr int BM = 256, BK = 64, HALF = 128, HTB = HALF * BK * 2, STAGE_BYTES = 8 * HTB, NXCD = 8, WGM = 8;
__host__ __device__ __forceinline__ int lds_byte(int r, int c) { const int st = (r >> 4) * 2 + (c >> 5), rr = r & 15, cc = c & 31, ob = rr * 64 + cc * 2; return st * 1024 + (ob ^ (((ob >> 9) & 1) << 5)); }
__host__ __device__ __forceinline__ void stage_rc(int b, int& R, int& C) { const int st = b / 1024, sb = b % 1024, swz = sb ^ (((sb >> 9) & 1) << 5); R = (st >> 1) * 16 + swz / 64; C = (st & 1) * 32 + (swz % 64) / 2; }
__host__ __device__ __forceinline__ int gray2(int b) { return b ^ (b >> 1); }
__host__ __device__ __forceinline__ void stage_rc8(int b, int& R, int& Cb) { const int st = b / 1024, w = b % 1024, rr = w / 64, p = (w % 64) / 16; R = (st >> 1) * 16 + rr; Cb = (st & 1) * 64 + (p ^ gray2(rr >> 2)) * 16; }
__host__ __device__ __forceinline__ int frag_off8(int row, int fq, int second) { const int rr = row & 15, c = 2 * (fq & 1) + second; return ((row >> 4) * 2 + (fq >> 1)) * 1024 + rr * 64 + ((c ^ gray2(rr >> 2)) * 16); }
__host__ __device__ __forceinline__ int perm32(int rho) { const int n = rho >> 4, i = rho & 15; return 8 * (i >> 2) + 4 * n + (i & 3); }

struct Unit { int pm, pn, pb, rel0, cnt, lb, half; };
struct Gemm { const bf16_t* A; const bf16_t* Bt; int K; };

__device__ __forceinline__ void order_map(int nM, int nN, int L, int& pm, int& pn) {
    const int nwg = nM * nN;
    int wgid = L; { const int q = nwg / NXCD, r = nwg % NXCD, xcd = wgid % NXCD, off = wgid / NXCD; wgid = (xcd < r ? xcd * (q + 1) : r * (q + 1) + (xcd - r) * q) + off; }
    const int nig = WGM * nN, gid = wgid / nig, fm = gid * WGM, gsz = (nM - fm) < WGM ? (nM - fm) : WGM;
    pm = fm + ((wgid % nig) % gsz); pn = (wgid % nig) / gsz;
}
struct DenseOrder {
    static constexpr bool GATHER = false;
    int nM, nN, G, c, K;
    __device__ __forceinline__ bool next(int i, Unit& u) const { const long L = (long)i * G + c; if (L >= nM * nN) return false; int pm, pn; order_map(nM, nN, (int)L, pm, pn);
        u.pm = pm; u.pn = pn; u.pb = pn; u.rel0 = 0; u.cnt = 0; u.lb = 0; u.half = 0; return true; }
    __device__ __forceinline__ void a_off(const Unit&, int, unsigned (&)[2][2]) const {}
};
template <bool GATHER_, bool Q8_ = false> struct MoeOrder {
    static constexpr bool GATHER = GATHER_;
    int nM, nN, G, c, K, tpe, split;
    const LAS int* tstart; const LAS int* ecnt; const int* list;
    __device__ __forceinline__ bool next(int i, Unit& u) const {
        const int U = nM * nN, R = U % G; const bool sp = split && R > 0 && 2 * R <= G;
        const long L = (long)i * G + c; if (L >= (sp ? U + R : U)) return false;
        int base = (int)L, half = 0;
        if (sp && L >= U - R) { const int Lp = (int)L - (U - R); base = (U - R) + (Lp >> 1); half = 1 + (Lp & 1); }
        int pm, pn; order_map(nM, nN, base, pm, pn);
        int e = 0;
#pragma unroll
        for (int k = 1; k < NE; ++k) e = (pm >= tstart[k]) ? k : e;
        u.pm = pm; u.pn = pn; u.pb = e * tpe + pn; u.rel0 = (pm - tstart[e]) * BM; u.cnt = ecnt[e]; u.lb = e * M; u.half = half; return true;
    }
    __device__ __forceinline__ void a_off(const Unit& u, int tid, unsigned (&vo)[2][2]) const {
        asm volatile("" : "+v"(tid));
#pragma unroll
        for (int i = 0; i < 2; ++i) { int R, Cb; if (Q8_) stage_rc8(tid * 16 + i * 8192, R, Cb); else { int C; stage_rc(tid * 16 + i * 8192, R, C); Cb = 2 * C; }
#pragma unroll
            for (int h = 0; h < 2; ++h) { const int rel = u.rel0 + (u.half == 2 ? HALF : 0) + (u.half ? 0 : h * HALF) + R; const int tok = rel < u.cnt ? list[u.lb + rel] : 0; vo[h][i] = (unsigned)(tok * K * (Q8_ ? 1 : 2) + Cb); } }
        asm volatile("s_waitcnt vmcnt(0)" ::: "memory");
    }
};

__device__ __forceinline__ f32x2 gelu_pk(f32x2 v) {
    const f32x2 av = __builtin_elementwise_abs(v), d = av * 0.2316418882f + 1.0f;
    f32x2 t; t.x = __builtin_amdgcn_rcpf(d.x); t.y = __builtin_amdgcn_rcpf(d.y);
    f32x2 q = t * 0.5307027145f + (-0.7265760135f); q = q * t + 0.7107068705f; q = q * t + (-0.142248368f); q = q * t + 0.127414796f; q = q * t;
    const f32x2 s = (v * v) * (-0.72134752044f);
    f32x2 e; e.x = __builtin_amdgcn_exp2f(s.x); e.y = __builtin_amdgcn_exp2f(s.y);
    const f32x2 m = v * (q * e), r = v - m;
    f32x2 o; o.x = v.x < 0.f ? m.x : r.x; o.y = v.y < 0.f ? m.y : r.y; return o;
}
__device__ __forceinline__ f32x4 gelu4(f32x4 v) { const f32x2 a = gelu_pk((f32x2){v[0], v[1]}), b = gelu_pk((f32x2){v[2], v[3]}); return (f32x4){a.x, a.y, b.x, b.y}; }
__device__ __forceinline__ float silu1(float x) { return x * __builtin_amdgcn_rcpf(1.0f + __builtin_amdgcn_exp2f(-x * LOG2E)); }

struct EpiIn {
    static constexpr bool PERM = true;
    bf16_t* Q; float* vstat; float oscale;
    __device__ __forceinline__ void operator()(const f32x4 (&acc)[2][2][4][2], const Unit& u, int wr, int wc, int fr, int fq) const {
        const int region = u.pn >> 2, ct = (u.pn & 3) * BM;
        bf16_t* base = Q + (size_t)region * ((size_t)M * 1024);
        const int row0 = u.pm * BM + (u.half == 2 ? HALF : 0) + wr * 64 + fr, col0 = ct + wc * 32 + 8 * fq; const int nai = u.half ? 1 : 2;
        const float sc = region == 0 ? QSCALE : 1.0f;
        const float os = oscale;
#pragma unroll
        for (int ai = 0; ai < 2; ++ai) if (ai < nai)
#pragma unroll
            for (int m = 0; m < 4; ++m) { const int row = row0 + ai * HALF + m * 16; bf16_t* rowp = base + (size_t)row * 1024 + col0; float s1 = 0.f, s2 = 0.f;
#pragma unroll
                for (int bj = 0; bj < 2; ++bj) { f32x4 v0 = acc[ai][bj][m][0] * os, v1 = acc[ai][bj][m][1] * os;
                    if (region >= 3) { v0 = gelu4(v0); v1 = gelu4(v1); }
                    if (region == 4) { s1 += (v0[0] + v0[1]) + (v0[2] + v0[3]) + (v1[0] + v1[1]) + (v1[2] + v1[3]);
                        s2 += (v0[0] * v0[0] + v0[1] * v0[1]) + (v0[2] * v0[2] + v0[3] * v0[3]) + (v1[0] * v1[0] + v1[1] * v1[1]) + (v1[2] * v1[2] + v1[3] * v1[3]); }
                    v0 = v0 * sc; v1 = v1 * sc; u32x4 w; w.x = cvt_pk_bf16(v0[0], v0[1]); w.y = cvt_pk_bf16(v0[2], v0[3]); w.z = cvt_pk_bf16(v1[0], v1[1]); w.w = cvt_pk_bf16(v1[2], v1[3]);
                    *(u32x4*)(rowp + bj * HALF) = w; }
                if (region == 4) { s1 += __shfl_xor(s1, 16); s1 += __shfl_xor(s1, 32); s2 += __shfl_xor(s2, 16); s2 += __shfl_xor(s2, 32);
                    if (fq == 0) *(f32x2*)(vstat + ((size_t)row * 16 + (u.pn & 3) * 4 + wc) * 2) = (f32x2){s1, s2}; } }
    }
};
struct EpiOut {
    static constexpr bool PERM = true;
    bf16_t* H; float oscale;
    __device__ __forceinline__ void operator()(const f32x4 (&acc)[2][2][4][2], const Unit& u, int wr, int wc, int fr, int fq) const {
        const int row0 = u.pm * BM + (u.half == 2 ? HALF : 0) + wr * 64 + fr, col0 = u.pn * BM + wc * 32 + 8 * fq; const int nai = u.half ? 1 : 2;
#pragma unroll
        for (int ai = 0; ai < 2; ++ai) if (ai < nai)
#pragma unroll
            for (int m = 0; m < 4; ++m) { bf16_t* rowp = H + (size_t)(row0 + ai * HALF + m * 16) * D + col0;
                u32x4 hv[2];
#pragma unroll
                for (int bj = 0; bj < 2; ++bj) hv[bj] = *(const u32x4*)(rowp + bj * HALF);
#pragma unroll
                for (int bj = 0; bj < 2; ++bj) { const f32x4 h0 = bf4_to_f32((u32x2){hv[bj].x, hv[bj].y}), h1 = bf4_to_f32((u32x2){hv[bj].z, hv[bj].w});
                    const f32x4 v0 = h0 * ALPHA + acc[ai][bj][m][0] * oscale, v1 = h1 * ALPHA + acc[ai][bj][m][1] * oscale;
                    u32x4 w; w.x = cvt_pk_bf16(v0[0], v0[1]); w.y = cvt_pk_bf16(v0[2], v0[3]); w.z = cvt_pk_bf16(v1[0], v1[1]); w.w = cvt_pk_bf16(v1[2], v1[3]);
                    *(u32x4*)(rowp + bj * HALF) = w; } }
    }
};
constexpr float SC_H = 16.0f, SC_O = 64.0f;
struct EpiGU {
    static constexpr bool PERM = true;
    fp8_t* Hid;
    __device__ __forceinline__ void operator()(const f32x4 (&acc)[2][2][4][2], const Unit& u, int wr, int wc, int fr, int fq) const {
        const int row0 = u.pm * BM + (u.half == 2 ? HALF : 0) + wr * 64 + fr, col0 = u.pn * HALF + wc * 32 + 8 * fq; const int nai = u.half ? 1 : 2;
#pragma unroll
        for (int ai = 0; ai < 2; ++ai) if (ai < nai)
#pragma unroll
            for (int m = 0; m < 4; ++m) { fp8_t* rowp = Hid + (size_t)(row0 + ai * HALF + m * 16) * FF + col0;
                const f32x4 g0 = acc[ai][0][m][0] * (1.0f / SC_W), g1 = acc[ai][0][m][1] * (1.0f / SC_W), u0 = acc[ai][1][m][0] * (SC_H / SC_W), u1 = acc[ai][1][m][1] * (SC_H / SC_W);
                float h[8];
#pragma unroll
                for (int j = 0; j < 4; ++j) { h[j] = silu1(g0[j]) * u0[j]; h[4 + j] = silu1(g1[j]) * u1[j]; }
                u32x2 w; w.x = pk4_fp8(h[0], h[1], h[2], h[3]); w.y = pk4_fp8(h[4], h[5], h[6], h[7]);
                *(u32x2*)rowp = w; }
    }
};
struct EpiDown {
    static constexpr bool PERM = true;
    fp8_t* Y;
    __device__ __forceinline__ void operator()(const f32x4 (&acc)[2][2][4][2], const Unit& u, int wr, int wc, int fr, int fq) const {
        const int row0 = u.pm * BM + (u.half == 2 ? HALF : 0) + wr * 64 + fr, col0 = u.pn * BM + wc * 32 + 8 * fq; const int nai = u.half ? 1 : 2;
        constexpr float os = SC_O / (SC_W * SC_H);
#pragma unroll
        for (int ai = 0; ai < 2; ++ai) if (ai < nai)
#pragma unroll
            for (int m = 0; m < 4; ++m) { fp8_t* rowp = Y + (size_t)(row0 + ai * HALF + m * 16) * D + col0;
#pragma unroll
                for (int bj = 0; bj < 2; ++bj) { const f32x4 v0 = acc[ai][bj][m][0] * os, v1 = acc[ai][bj][m][1] * os;
                    u32x2 w; w.x = pk4_fp8(v0[0], v0[1], v0[2], v0[3]); w.y = pk4_fp8(v1[0], v1[1], v1[2], v1[3]);
                    *(u32x2*)(rowp + bj * HALF) = w; } }
    }
};

template <class Epi, class Sched, bool Q8 = false>
__device__ __forceinline__ void gemm_phase(LAS unsigned char* lds, LAS unsigned char* park, const Gemm g, const Sched& S, const Epi& E, int wv) {
    int tid = TIDX(wv); asm volatile("" : "+v"(tid));
    const int wid = __builtin_amdgcn_readfirstlane(tid >> 6), lane = tid & 63, wr = wid >> 2, wc = wid & 3, fr = lane & 15, fq = lane >> 4;
    constexpr bool GA = Sched::GATHER;
    constexpr int ESZ = Q8 ? 1 : 2;
    const int K = g.K, nt = K * ESZ / 128;
    unsigned voffA[2], voffB[2];
#pragma unroll
    for (int i = 0; i < 2; ++i) { int R, Cb; if (Q8) stage_rc8(tid * 16 + i * 8192, R, Cb); else { int C; stage_rc(tid * 16 + i * 8192, R, C); Cb = 2 * C; }
        const int Rb = Epi::PERM ? ((R & ~31) + perm32(R & 31)) : R; voffA[i] = (unsigned)(R * K * ESZ + Cb); voffB[i] = (unsigned)(Rb * K * ESZ + Cb); }
    const size_t kstep = (size_t)128;
    const size_t hstep = (size_t)HALF * K * ESZ;
    const size_t tstep = 2 * hstep;
    const unsigned ldsw = (unsigned)wid * 1024u;
    const int aoff = Q8 ? frag_off8(wr * 64 + fr, fq, 0) : lds_byte(wr * 64 + fr, fq * 8), boff = Q8 ? frag_off8(wc * 32 + fr, fq, 0) : lds_byte(wc * 32 + fr, fq * 8);
    const int aoff1 = Q8 ? frag_off8(wr * 64 + fr, fq, 1) : aoff + 1024;
    int boffh = boff + 65536; asm volatile("" : "+v"(boffh));
    int boffh1 = (Q8 ? frag_off8(wc * 32 + fr, fq, 1) : boff + 1024) + 65536; asm volatile("" : "+v"(boffh1));
#define PG8_SA(b, h) (((b) * 2 + (h)) * HTB)
#define PG8_SB(b, h) ((4 + (b) * 2 + (h)) * HTB)
#define PG8_STAGE(bufoff, gbase, voff) do { _Pragma("unroll") for (int _i = 0; _i < 2; ++_i) \
        __builtin_amdgcn_global_load_lds((const unsigned*)((const char*)(gbase) + (voff)[_i]), (LAS unsigned*)(lds + (bufoff) + ldsw + _i * 8192), 16, 0, 0); } while (0)
#define PG8_STAGE_A(bufoff, h, ap, hs, kb) do { if constexpr (GA) { _Pragma("unroll") for (int _i = 0; _i < 2; ++_i) \
        __builtin_amdgcn_global_load_lds((const unsigned*)(Abase + (kb) + vc[h][_i]), (LAS unsigned*)(lds + (bufoff) + ldsw + _i * 8192), 16, 0, 0); } \
        else PG8_STAGE(bufoff, (ap) + ((h) ? (hs) : (size_t)0) + (kb), voffA); } while (0)
#define PG8_LDF(dst, base0, base1) do { if constexpr (Q8) { const u32x4 lo_ = *(const LAS u32x4*)(lds + (base0)), hi_ = *(const LAS u32x4*)(lds + (base1)); \
        dst.q = __builtin_bit_cast(v8i, __builtin_shufflevector(lo_, hi_, 0, 1, 2, 3, 4, 5, 6, 7)); } \
        else { dst.k[0] = *(const LAS bf16x8*)(lds + (base0)); dst.k[1] = *(const LAS bf16x8*)(lds + (base1)); } } while (0)
#define PG8_LDA(dst, b, h) do { _Pragma("unroll") for (int m = 0; m < 4; ++m) PG8_LDF(dst[m], PG8_SA(b, h) + aoff + m * 2048, PG8_SA(b, h) + aoff1 + m * 2048); } while (0)
#define PG8_LDB(dst, b, h) do { _Pragma("unroll") for (int n = 0; n < 2; ++n) PG8_LDF(dst[n], (PG8_SB(b, h) - 65536) + boffh + n * 2048, (PG8_SB(b, h) - 65536) + boffh1 + n * 2048); } while (0)
#define PG8_MMA(ai, bj, At, Bt) do { __builtin_amdgcn_s_setprio(1); if constexpr (Q8) { _Pragma("unroll") for (int m = 0; m < 4; ++m) _Pragma("unroll") for (int n = 0; n < 2; ++n) \
        asm volatile("v_mfma_scale_f32_16x16x128_f8f6f4 %0, %1, %2, %0, %3, %3 op_sel_hi:[0,0,0]" : "+v"(acc[ai][bj][m][n]) : "v"(Bt[n].q), "v"(At[m].q), "v"(qscale)); } \
        else { _Pragma("unroll") for (int m = 0; m < 4; ++m) _Pragma("unroll") for (int n = 0; n < 2; ++n) _Pragma("unroll") for (int k = 0; k < 2; ++k) \
        acc[ai][bj][m][n] = __builtin_amdgcn_mfma_f32_16x16x32_bf16(Bt[n].k[k], At[m].k[k], acc[ai][bj][m][n], 0, 0, 0); } __builtin_amdgcn_s_setprio(0); } while (0)
#define PG8_WAIT_V(n) asm volatile("s_waitcnt vmcnt(" #n ")" ::: "memory")
#define PG8_WAIT_L(n) asm volatile("s_waitcnt lgkmcnt(" #n ")" ::: "memory")
#define PG8_BAR __builtin_amdgcn_s_barrier()
#define PG8_SCHED __builtin_amdgcn_sched_barrier(0)
    Unit cur, nxt; int ui = 0;
    if (!S.next(0, cur)) return;
    f32x4 acc[2][2][4][2];
#pragma unroll
    for (int a = 0; a < 2; ++a)
#pragma unroll
        for (int b = 0; b < 2; ++b)
#pragma unroll
            for (int m = 0; m < 4; ++m)
#pragma unroll
                for (int n = 0; n < 2; ++n) acc[a][b][m][n] = (f32x4){0.f, 0.f, 0.f, 0.f};
    Frag<Q8> At[4], B0[2], B1[2];
    int qscale = 0x7f7f7f7f; if constexpr (Q8) asm volatile("" : "+v"(qscale));
    unsigned vc[2][2];
    LAS u32x4* const mypark = (LAS u32x4*)(park + tid * 16);
    if constexpr (GA) S.a_off(cur, tid, vc);
    const char* const Abase = (const char*)g.A;
    const char* cA = Abase + (size_t)cur.pm * tstep + (cur.half == 2 ? hstep : (size_t)0); size_t chs = cur.half ? (size_t)0 : hstep;
    const char* cB = (const char*)g.Bt + (size_t)cur.pb * tstep;
    PG8_STAGE(PG8_SB(0, 0), cB, voffB); PG8_STAGE(PG8_SB(0, 1), cB + hstep, voffB); PG8_STAGE_A(PG8_SA(0, 0), 0, cA, chs, 0); PG8_STAGE_A(PG8_SA(0, 1), 1, cA, chs, 0);
    if (wr == 1) PG8_BAR;
    PG8_WAIT_V(2); PG8_BAR;
    PG8_STAGE(PG8_SB(1, 0), cB + kstep, voffB); PG8_STAGE_A(PG8_SA(1, 0), 0, cA, chs, kstep); PG8_STAGE(PG8_SB(1, 1), cB + hstep + kstep, voffB);
    PG8_WAIT_V(6); PG8_BAR;
    for (;;) {
        const bool has_next = S.next(ui + 1, nxt);
        if constexpr (GA) { if (has_next) { unsigned vn[2][2]; S.a_off(nxt, tid, vn); *mypark = (u32x4){vn[0][0], vn[0][1], vn[1][0], vn[1][1]}; } }
        const char* nA = has_next ? Abase + (size_t)nxt.pm * tstep + (nxt.half == 2 ? hstep : (size_t)0) : cA; const size_t nhs = has_next ? (nxt.half ? (size_t)0 : hstep) : chs;
        const bool full = cur.half == 0;
        const char* nB = has_next ? (const char*)g.Bt + (size_t)nxt.pb * tstep : cB;
        for (int t = 0; t < nt; t += 2) {
            const bool last = (t == nt - 2);
            const size_t ka1 = (size_t)(t + 1) * kstep;
            const size_t ka2 = last ? (size_t)0 : (size_t)(t + 2) * kstep, ka3 = ka2 + kstep;
            const char* a2 = last ? nA : cA; const size_t hs2 = last ? nhs : chs;
            const char* b2 = last ? nB : cB + (size_t)(t + 2) * kstep; const char* b3 = b2 + kstep;
            PG8_LDB(B0, 0, 0); PG8_LDB(B1, 0, 1); PG8_SCHED; PG8_LDA(At, 0, 0); PG8_STAGE_A(PG8_SA(1, 1), 1, cA, chs, ka1);
            PG8_WAIT_V(8); PG8_WAIT_L(0); PG8_BAR; PG8_MMA(0, 0, At, B0); PG8_MMA(0, 1, At, B1); PG8_BAR; PG8_SCHED;
            if constexpr (GA) { if (last && has_next) { const u32x4 pv = *mypark; vc[0][0] = pv.x; vc[0][1] = pv.y; vc[1][0] = pv.z; vc[1][1] = pv.w; } }
            if (full) PG8_LDA(At, 0, 1); PG8_STAGE(PG8_SB(0, 0), b2, voffB); PG8_STAGE(PG8_SB(0, 1), b2 + hstep, voffB); PG8_STAGE_A(PG8_SA(0, 0), 0, a2, hs2, ka2);
            PG8_WAIT_V(8); PG8_WAIT_L(0); PG8_BAR; if (full) { PG8_MMA(1, 0, At, B0); PG8_MMA(1, 1, At, B1); } PG8_BAR; PG8_SCHED;
            PG8_LDB(B0, 1, 0); PG8_LDB(B1, 1, 1); PG8_SCHED; PG8_LDA(At, 1, 0); PG8_STAGE_A(PG8_SA(0, 1), 1, a2, hs2, ka2);
            PG8_WAIT_V(8); PG8_WAIT_L(0); PG8_BAR; PG8_MMA(0, 0, At, B0); PG8_MMA(0, 1, At, B1); PG8_BAR; PG8_SCHED;
            if (full) PG8_LDA(At, 1, 1); PG8_STAGE(PG8_SB(1, 0), b3, voffB); PG8_STAGE(PG8_SB(1, 1), b3 + hstep, voffB); PG8_STAGE_A(PG8_SA(1, 0), 0, a2, hs2, ka3);
            PG8_WAIT_V(8); PG8_WAIT_L(0); PG8_BAR; if (full) { PG8_MMA(1, 0, At, B0); PG8_MMA(1, 1, At, B1); } PG8_BAR; PG8_SCHED;
        }
        if (wr == 0) PG8_BAR;
        if constexpr (Q8) asm volatile("s_nop 15\n\ts_nop 15" ::: "memory");
        E(acc, cur, wr, wc, fr, fq);
        if (!has_next) break;
#pragma unroll
        for (int a = 0; a < 2; ++a)
#pragma unroll
            for (int b = 0; b < 2; ++b)
#pragma unroll
                for (int m = 0; m < 4; ++m)
#pragma unroll
                    for (int n = 0; n < 2; ++n) acc[a][b][m][n] = (f32x4){0.f, 0.f, 0.f, 0.f};
        cur = nxt; cA = nA; cB = nB; chs = nhs; ++ui;
        if (wr == 1) PG8_BAR;
    }
    PG8_WAIT_V(0);
    PG8_BAR;
#undef PG8_SA
#undef PG8_SB
#undef PG8_STAGE
#undef PG8_STAGE_A
#undef PG8_LDA
#undef PG8_LDB
#undef PG8_MMA
#undef PG8_WAIT_V
#undef PG8_WAIT_L
#undef PG8_BAR
#undef PG8_SCHED
}
}

#define KSWZ(row, colB) ((row) * 256 + ((colB) ^ (((row) & 7) << 4)))
__device__ __forceinline__ int crow(int r, int hi) { return (r & 3) + 8 * (r >> 2) + 4 * hi; }
__device__ __forceinline__ int v_st(int k, int c) { const int kk = (k & ~0xC) | ((k & 4) << 1) | ((k & 8) >> 1); return ((kk >> 3) * 4 + (c >> 5)) * 512 + ((kk & 7) * 32 + (c & 31)) * 2; }
__device__ __forceinline__ int v_rd_base(int lane) { return ((lane & 3) << 3) | (((lane >> 2) & 3) << 6) | (((lane >> 4) & 1) << 5) | (((lane >> 5) & 1) << 8); }
constexpr int v_rd_off(int d0, int ks, int half) { return d0 * 512 + ks * 4096 + half * 2048; }
template <int OFF> __device__ __forceinline__ s16x4 tr_read(unsigned vb) {
    s16x4 r; asm volatile("ds_read_b64_tr_b16 %0, %1 offset:%2" : "=&v"(r) : "v"(vb), "i"(OFF) : "memory"); return r;
}
#define PKF(L, H) (bf16x8){L[0], L[1], L[2], L[3], H[0], H[1], H[2], H[3]}
template <int D0> __device__ __forceinline__ void pv_one(f32x16& od, unsigned vb, bf16x8 pa0, bf16x8 pa1, bf16x8 pa2, bf16x8 pa3) {
    const s16x4 l0 = tr_read<v_rd_off(D0, 0, 0)>(vb), h0 = tr_read<v_rd_off(D0, 0, 1)>(vb), l1 = tr_read<v_rd_off(D0, 1, 0)>(vb), h1 = tr_read<v_rd_off(D0, 1, 1)>(vb);
    const s16x4 l2 = tr_read<v_rd_off(D0, 2, 0)>(vb), h2 = tr_read<v_rd_off(D0, 2, 1)>(vb), l3 = tr_read<v_rd_off(D0, 3, 0)>(vb), h3 = tr_read<v_rd_off(D0, 3, 1)>(vb);
    asm volatile("s_waitcnt lgkmcnt(0)" ::: "memory"); SBAR();
    od = __builtin_amdgcn_mfma_f32_32x32x16_bf16(pa0, PKF(l0, h0), od, 0, 0, 0);
    od = __builtin_amdgcn_mfma_f32_32x32x16_bf16(pa1, PKF(l1, h1), od, 0, 0, 0);
    od = __builtin_amdgcn_mfma_f32_32x32x16_bf16(pa2, PKF(l2, h2), od, 0, 0, 0);
    od = __builtin_amdgcn_mfma_f32_32x32x16_bf16(pa3, PKF(l3, h3), od, 0, 0, 0);
}
template <int D0, int KS> __device__ __forceinline__ void pv_step(f32x16& od, unsigned vb, bf16x8 pa) {
    const s16x4 l0 = tr_read<v_rd_off(D0, KS, 0)>(vb), h0 = tr_read<v_rd_off(D0, KS, 1)>(vb);
    asm volatile("s_waitcnt lgkmcnt(0)" ::: "memory"); SBAR();
    od = __builtin_amdgcn_mfma_f32_32x32x16_bf16(pa, PKF(l0, h0), od, 0, 0, 0);
}

constexpr float ATT_THRL = 11.5f;

__device__ __forceinline__ void attn_unit(LAS unsigned char* lds, LAS unsigned char* ldc, const bf16_t* Qb, const bf16_t* Kb, const bf16_t* Vb, fp8_t* Ycat, const float* relb, int b, int h, int qb, int wv) {
    int tid = TIDX(wv); asm volatile("" : "+v"(tid));
    const int wid = __builtin_amdgcn_readfirstlane(tid >> 6), lane = tid & 63, r32 = lane & 31, hi = lane >> 5;
    LAS unsigned char* V_lds = lds; LAS unsigned char* K_lds = lds + 65536;
    LAS float* tb = (LAS float*)(ldc + LC_PARK);
    LAS float* wsf = (LAS float*)(ldc + LC_PARK + 2048) + wid * 64; LAS float* li_l = wsf; LAS float* al_l = wsf + 32;
    __syncthreads();
    for (int i = tid; i < NREL; i += 512) tb[i] = relb[i] * LOG2E;
    const int seqrow0 = b * SEQ, c0 = 4 * qb, t0 = c0 >= 8 ? c0 - 8 : 0, jend = c0 + 3, cw = c0 + (wid >> 1), nms = (jend - t0 + 1) >> 1;
    float m_reg = -1e30f, l_reg = 0.f; f32x16 o[4];
#pragma unroll
    for (int d = 0; d < 4; ++d)
#pragma unroll
        for (int r = 0; r < 16; ++r) o[d][r] = 0.f;
    bf16x8 qr[8];
    { const bf16_t* Qw = Qb + (size_t)(seqrow0 + qb * 256 + wid * 32 + r32) * AW + h * HD + hi * 8;
#pragma unroll
      for (int d0 = 0; d0 < 8; ++d0) qr[d0] = *(const bf16x8*)(Qw + d0 * 16); }
    const int sr = tid >> 4, sc = (tid & 15) * 8, vst0 = v_st(sr, sc), vst1 = v_st(32 + sr, sc);
    const unsigned vb0 = (unsigned)(size_t)V_lds + (unsigned)v_rd_base(lane);
    bf16x8 ks0, ks1, vs0, vs1;
#define ASLOAD(jj) do { const size_t kr = (size_t)(seqrow0 + (jj) * 64 + sr) * AW + h * HD + sc; \
        ks0 = *(const bf16x8*)(Kb + kr); ks1 = *(const bf16x8*)(Kb + kr + 32 * AW); vs0 = *(const bf16x8*)(Vb + kr); vs1 = *(const bf16x8*)(Vb + kr + 32 * AW); } while (0)
#define ASWRITE(ts) do { *(LAS bf16x8*)(V_lds + (ts) * 16384 + vst0) = vs0; *(LAS bf16x8*)(V_lds + (ts) * 16384 + vst1) = vs1; \
        *(LAS bf16x8*)(K_lds + (ts) * 16384 + KSWZ(sr, sc * 2)) = ks0; *(LAS bf16x8*)(K_lds + (ts) * 16384 + KSWZ(32 + sr, sc * 2)) = ks1; } while (0)
#define PK4(P, BASE, OUT) do { unsigned a0 = cvt_pk_bf16(P[BASE + 0], P[BASE + 1]), a1 = cvt_pk_bf16(P[BASE + 2], P[BASE + 3]);   \
    unsigned b0 = cvt_pk_bf16(P[BASE + 4], P[BASE + 5]), b1 = cvt_pk_bf16(P[BASE + 6], P[BASE + 7]);                              \
    auto r0 = __builtin_amdgcn_permlane32_swap(a0, b0, false, false); auto r1 = __builtin_amdgcn_permlane32_swap(a1, b1, false, false); \
    u32x4 w = {r0[0], r1[0], r0[1], r1[1]}; OUT = __builtin_bit_cast(bf16x8, w); } while (0)
#define ATT_TILE(j, ts) do { if ((j) >= cw - 8 && (j) <= cw) { \
            f32x16 p0, p1; \
            _Pragma("unroll") for (int r = 0; r < 16; ++r) { p0[r] = 0.f; p1[r] = 0.f; } \
            const LAS unsigned char* Ks = K_lds + (ts) * 16384; \
            _Pragma("unroll") for (int d0 = 0; d0 < 8; ++d0) { const int cb = (d0 * 16 + hi * 8) * 2; \
                const bf16x8 b0 = *(const LAS bf16x8*)(Ks + KSWZ(r32, cb)); \
                const bf16x8 b1 = *(const LAS bf16x8*)(Ks + KSWZ(32 + r32, cb)); \
                p0 = __builtin_amdgcn_mfma_f32_32x32x16_bf16(b0, qr[d0], p0, 0, 0, 0); \
                p1 = __builtin_amdgcn_mfma_f32_32x32x16_bf16(b1, qr[d0], p1, 0, 0, 0); } \
            const int dj = cw - (j); \
            if (dj >= 3) { const float cbias = tb[256]; \
                _Pragma("unroll") for (int r = 0; r < 16; ++r) { p0[r] += cbias; p1[r] += cbias; } } \
            else { const int bb = 64 * dj + 32 * (wid & 1) + r32 + 128; \
                _Pragma("unroll") for (int r = 0; r < 16; ++r) { const int i0 = bb - crow(r, hi), i1 = i0 - 32; p0[r] += tb[i0 > 256 ? 256 : i0]; p1[r] += tb[i1 > 256 ? 256 : i1]; } } \
            float pmax = p0[0]; \
            _Pragma("unroll") for (int r = 1; r < 16; ++r) pmax = fmaxf(pmax, p0[r]); \
            _Pragma("unroll") for (int r = 0; r < 16; ++r) pmax = fmaxf(pmax, p1[r]); \
            { auto rr = __builtin_amdgcn_permlane32_swap(__float_as_uint(pmax), __float_as_uint(pmax), false, false); \
              pmax = fmaxf(__uint_as_float(rr[0]), __uint_as_float(rr[1])); } \
            float mn, alpha; \
            if (__all(pmax - m_reg <= ATT_THRL)) { mn = m_reg; alpha = 1.f; } \
            else { mn = fmaxf(m_reg, pmax); alpha = __builtin_amdgcn_exp2f(m_reg - mn); m_reg = mn; } \
            float ps = 0.f; \
            _Pragma("unroll") for (int r = 0; r < 16; ++r) { p0[r] = __builtin_amdgcn_exp2f(p0[r] - mn); p1[r] = __builtin_amdgcn_exp2f(p1[r] - mn); ps += p0[r] + p1[r]; } \
            { auto rr = __builtin_amdgcn_permlane32_swap(__float_as_uint(ps), __float_as_uint(ps), false, false); \
              ps = __uint_as_float(rr[0]) + __uint_as_float(rr[1]); } \
            l_reg = l_reg * alpha + ps; \
            if (__any(alpha < 1.f)) { if (hi == 0) al_l[r32] = alpha; LDS_WAIT(); \
                _Pragma("unroll") for (int r = 0; r < 16; ++r) { const float a_ = al_l[crow(r, hi)]; \
                    _Pragma("unroll") for (int d = 0; d < 4; ++d) o[d][r] *= a_; } } \
            bf16x8 pa0, pa1, pa2, pa3; \
            PK4(p0, 0, pa0); PK4(p0, 8, pa1); PK4(p1, 0, pa2); PK4(p1, 8, pa3); \
            const unsigned vb = vb0 + (unsigned)(ts) * 16384u; \
            pv_one<0>(o[0], vb, pa0, pa1, pa2, pa3); pv_one<1>(o[1], vb, pa0, pa1, pa2, pa3); pv_one<2>(o[2], vb, pa0, pa1, pa2, pa3); pv_one<3>(o[3], vb, pa0, pa1, pa2, pa3); } } while (0)
    ASLOAD(t0); ASWRITE(0); ASLOAD(t0 + 1); ASWRITE(1); if (nms > 1) ASLOAD(t0 + 2);
    for (int ms = 0; ms < nms; ++ms) {
        const int buf = ms & 1, jA = t0 + 2 * ms; const bool more = ms + 1 < nms;
        __syncthreads();
        if (more) { ASWRITE((buf ^ 1) * 2); ASLOAD(jA + 3); }
        ATT_TILE(jA, buf * 2);
        if (more) { ASWRITE((buf ^ 1) * 2 + 1); if (ms + 2 < nms) ASLOAD(jA + 4); }
        ATT_TILE(jA + 1, buf * 2 + 1);
    }
#undef ATT_TILE
#undef PK4
#undef ASLOAD
#undef ASWRITE
    if (hi == 0) li_l[r32] = l_reg; LDS_WAIT();
    fp8_t* Ow = Ycat + (size_t)(seqrow0 + qb * 256 + wid * 32) * D + h * HD + r32;
#pragma unroll
    for (int r = 0; r < 16; ++r) { const int orow = crow(r, hi); const float rl = __builtin_amdgcn_rcpf(li_l[orow]) * SC_Y;
#pragma unroll
        for (int d0 = 0; d0 < 4; ++d0) Ow[(size_t)orow * D + d0 * 32] = f2fp8(o[d0][r] * rl); }
}

__device__ __forceinline__ void sgu_unit(LAS unsigned char* lds, LAS unsigned char* ldc, const bf16_t* Ub, const bf16_t* Vsb, const float* vstat, const float* lng, const float* lnb,
                                         const float* Wg, const float* bsg, fp8_t* Ycat, int b, int nb, int g, int wv) {
    int tid = TIDX(wv); asm volatile("" : "+v"(tid));
    const int wid = __builtin_amdgcn_readfirstlane(tid >> 6), lane = tid & 63, r32 = lane & 31, hi = lane >> 5;
    LAS f32x2* st = (LAS f32x2*)(ldc + LC_SGUST);
    const int row0 = b * SEQ + nb * 128;
    const int rb = wid >> 1, dh = wid & 1, t = 32 * rb + r32;
    const int sr = tid >> 4, sc = (tid & 15) * 8;
    f32x2 sp[16];
    if (tid < 128) { const f32x2* p = (const f32x2*)(vstat + (size_t)(row0 + tid) * 32);
#pragma unroll
        for (int i = 0; i < 16; ++i) sp[i] = p[i]; }
    bf16x8 xv[4];
#pragma unroll
    for (int k = 0; k < 4; ++k) xv[k] = *(const bf16x8*)(Vsb + (size_t)(row0 + sr + 32 * k) * SW + g * 128 + sc);
    const f32x4 g0 = *(const f32x4*)(lng + g * 128 + sc), g1 = *(const f32x4*)(lng + g * 128 + sc + 4), b0 = *(const f32x4*)(lnb + g * 128 + sc), b1 = *(const f32x4*)(lnb + g * 128 + sc + 4);
    const float* wrow = Wg + (size_t)t * 128 + 8 * hi;
    f32x4 wf[8][2];
#pragma unroll
    for (int ks = 0; ks < 8; ++ks) { wf[ks][0] = *(const f32x4*)(wrow + 16 * ks); wf[ks][1] = *(const f32x4*)(wrow + 16 * ks + 4); }
    __syncthreads();
    if (tid < 128) { float s1 = 0.f, s2 = 0.f;
#pragma unroll
        for (int i = 0; i < 16; ++i) { s1 += sp[i].x; s2 += sp[i].y; }
        const float mean = s1 * (1.f / SW); float var = s2 * (1.f / SW) - mean * mean; var = var > 0.f ? var : 0.f;
        st[tid] = (f32x2){mean, 1.0f / sqrtf(var + LN_EPS)}; }
    __syncthreads();
#pragma unroll
    for (int k = 0; k < 4; ++k) { const int row = sr + 32 * k; const bf16x8 x = xv[k]; const f32x2 ms = st[row];
        float y[8];
#pragma unroll
        for (int i = 0; i < 4; ++i) { y[i] = (bf2f((unsigned short)x[i]) - ms.x) * ms.y * g0[i] + b0[i]; y[4 + i] = (bf2f((unsigned short)x[4 + i]) - ms.x) * ms.y * g1[i] + b1[i]; }
        u32x4 w; w.x = cvt_pk_bf16(y[0], y[1]); w.y = cvt_pk_bf16(y[2], y[3]); w.z = cvt_pk_bf16(y[4], y[5]); w.w = cvt_pk_bf16(y[6], y[7]);
        *(LAS u32x4*)(lds + (row >> 6) * 16384 + v_st(row & 63, sc)) = w; }
    unsigned short uu[16][2]; float bsv[16];
#pragma unroll
    for (int r = 0; r < 16; ++r) { const int tt = 32 * rb + crow(r, hi); bsv[r] = bsg[tt];
#pragma unroll
        for (int di = 0; di < 2; ++di) uu[r][di] = Ub[(size_t)(row0 + tt) * SW + g * 128 + 32 * (2 * dh + di) + r32]; }
    __syncthreads();
    f32x16 o0, o1;
#pragma unroll
    for (int r = 0; r < 16; ++r) { o0[r] = 0.f; o1[r] = 0.f; }
    const unsigned vb0 = (unsigned)(size_t)lds + (unsigned)v_rd_base(lane);
#define SGU_STEP(KS) do { if ((KS) <= 2 * rb + 1) { const int s0 = 16 * (KS) + 8 * hi; const f32x4 wa = wf[KS][0], wb = wf[KS][1]; \
        float wv[8] = {wa[0], wa[1], wa[2], wa[3], wb[0], wb[1], wb[2], wb[3]}; \
        _Pragma("unroll") for (int i = 0; i < 8; ++i) wv[i] = (s0 + i <= t) ? wv[i] : 0.f; \
        u32x4 w; w.x = cvt_pk_bf16(wv[0], wv[1]); w.y = cvt_pk_bf16(wv[2], wv[3]); w.z = cvt_pk_bf16(wv[4], wv[5]); w.w = cvt_pk_bf16(wv[6], wv[7]); \
        const bf16x8 pa = __builtin_bit_cast(bf16x8, w); const unsigned vb = vb0 + (unsigned)(((KS) >> 2) * 16384); \
        if (dh == 0) { pv_step<0, (KS) & 3>(o0, vb, pa); pv_step<1, (KS) & 3>(o1, vb, pa); } else { pv_step<2, (KS) & 3>(o0, vb, pa); pv_step<3, (KS) & 3>(o1, vb, pa); } } } while (0)
    SGU_STEP(0); SGU_STEP(1); SGU_STEP(2); SGU_STEP(3); SGU_STEP(4); SGU_STEP(5); SGU_STEP(6); SGU_STEP(7);
#undef SGU_STEP
#pragma unroll
    for (int r = 0; r < 16; ++r) { const int tt = 32 * rb + crow(r, hi); const size_t row = (size_t)(row0 + tt);
#pragma unroll
        for (int di = 0; di < 2; ++di) { const int c = 32 * (2 * dh + di) + r32; const float ov = di == 0 ? o0[r] : o1[r];
            Ycat[row * D + AW + g * 128 + c] = f2fp8(bf2f(uu[r][di]) * (ov + bsv[r]) * SC_Y); } }
}

#ifndef PH_MASK
#define PH_MASK 0x1ff
#endif
#define PH(k) ((PH_MASK >> (k)) & 1)
#ifndef MOE_SPLIT
#define MOE_SPLIT(l) ((l) == DEPTH - 1 ? 1 : 0)
#endif
#ifndef REP_MASK
#define REP_MASK 0
#endif
#define NREP(k) (((REP_MASK >> (k)) & 1) ? 2 : 1)
struct Args { const float* in[19]; float* out; unsigned char* ws; };
enum { I_X = 0, I_LNG, I_LNB, I_WIN, I_REL, I_SLNG, I_SLNB, I_SW, I_SB, I_WOUT, I_L1G, I_L1B, I_RW, I_RB, I_WG, I_WU, I_WD, I_L2G, I_L2B };

struct TItem { const float* src; void* dst; int N, Kd, q8; };
__device__ __forceinline__ void titem_load(const TItem& t, int lane, f32x4 (&v)[16]) {
    const float* p = t.src + (size_t)(16 * (lane >> 3)) * t.N + 4 * (lane & 7);
#pragma unroll
    for (int i = 0; i < 16; ++i) v[i] = __builtin_nontemporal_load((const f32x4*)(p + (size_t)i * t.N));
}
__device__ __forceinline__ void titem_store(const TItem& t, int lane, const f32x4 (&v)[16]) {
    if (t.q8) { fp8_t* q = (fp8_t*)t.dst + (size_t)(4 * (lane & 7)) * t.Kd + 16 * (lane >> 3);
#pragma unroll
        for (int c = 0; c < 4; ++c) { u32x4 o; o.x = pk4_fp8(v[0][c] * SC_W, v[1][c] * SC_W, v[2][c] * SC_W, v[3][c] * SC_W); o.y = pk4_fp8(v[4][c] * SC_W, v[5][c] * SC_W, v[6][c] * SC_W, v[7][c] * SC_W);
            o.z = pk4_fp8(v[8][c] * SC_W, v[9][c] * SC_W, v[10][c] * SC_W, v[11][c] * SC_W); o.w = pk4_fp8(v[12][c] * SC_W, v[13][c] * SC_W, v[14][c] * SC_W, v[15][c] * SC_W);
            __builtin_nontemporal_store(o, (u32x4*)(q + (size_t)c * t.Kd)); }
    } else { bf16_t* q = (bf16_t*)t.dst + (size_t)(4 * (lane & 7)) * t.Kd + 16 * (lane >> 3);
#pragma unroll
        for (int c = 0; c < 4; ++c) { u32x4 o0, o1; o0.x = cvt_pk_bf16(v[0][c], v[1][c]); o0.y = cvt_pk_bf16(v[2][c], v[3][c]); o0.z = cvt_pk_bf16(v[4][c], v[5][c]); o0.w = cvt_pk_bf16(v[6][c], v[7][c]);
            o1.x = cvt_pk_bf16(v[8][c], v[9][c]); o1.y = cvt_pk_bf16(v[10][c], v[11][c]); o1.z = cvt_pk_bf16(v[12][c], v[13][c]); o1.w = cvt_pk_bf16(v[14][c], v[15][c]);
            __builtin_nontemporal_store(o0, (u32x4*)(q + (size_t)c * t.Kd)); __builtin_nontemporal_store(o1, (u32x4*)(q + (size_t)c * t.Kd + 8)); }
    }
}
constexpr int CV_IN = 16 * 160, CV_OUT = 16 * 64, CV_E = 512, CV_LAYER = CV_IN + CV_OUT + NE * 3 * CV_E, CV_TOTAL = DEPTH * CV_LAYER;
__device__ __forceinline__ TItem titem_decode(int it, const float* w_in, const float* w_out, const float* w_g, const float* w_u, const float* w_d, fp8_t* WinQ, bf16_t* WoutT, fp8_t* WguQ, fp8_t* WdQ) {
    TItem t; const int l = it / CV_LAYER; int r = it - l * CV_LAYER;
    if (r < CV_IN) { const int kb = r / 160, nb = r % 160; t.q8 = 1; t.N = NIN; t.Kd = D; t.src = w_in + (size_t)l * D * NIN + (size_t)(128 * kb) * NIN + 32 * nb; t.dst = WinQ + (size_t)l * NIN * D + (size_t)(32 * nb) * D + 128 * kb; return t; }
    r -= CV_IN;
    if (r < CV_OUT) { const int kb = r / 64, nb = r % 64; t.q8 = 1; t.N = D; t.Kd = D; t.src = w_out + (size_t)l * D * D + (size_t)(128 * kb) * D + 32 * nb; t.dst = (fp8_t*)WoutT + (size_t)l * D * D + (size_t)(32 * nb) * D + 128 * kb; return t; }
    r -= CV_OUT;
    const int e = r / (3 * CV_E), rr = r % (3 * CV_E), which = rr / CV_E, idx = rr % CV_E; const size_t le = (size_t)l * NE + e; t.q8 = 1;
    if (which < 2) { const int kb = idx / 32, nb = idx % 32, n0 = 32 * nb;
        t.N = FF; t.Kd = D; t.src = (which == 0 ? w_g : w_u) + le * D * FF + (size_t)(128 * kb) * FF + n0; t.dst = WguQ + le * (size_t)(2 * FF) * D + (size_t)((n0 >> 7) * 256 + which * 128 + (n0 & 127)) * D + 128 * kb; }
    else { const int kb = idx / 64, nb = idx % 64;
        t.N = D; t.Kd = FF; t.src = w_d + le * FF * D + (size_t)(128 * kb) * D + 32 * nb; t.dst = WdQ + le * (size_t)D * FF + (size_t)(32 * nb) * FF + 128 * kb; }
    return t;
}
constexpr int CV_AB = CV_IN + CV_OUT, CV_GU = NE * 2 * CV_E, CV_DN = NE * CV_E;
constexpr int CVQ_B = CV_AB, CVQ_C = CVQ_B + CV_GU, CVQ_D = CVQ_C + CV_DN, CVQ_E = CVQ_D + CV_AB, CVQ_F = CVQ_E + CV_GU;
static_assert(CVQ_D == CV_LAYER && CVQ_F + CV_DN == CV_TOTAL, "class layout");
#ifndef CV_S1
#define CV_S1 7000
#endif
#ifndef CV_S2
#define CV_S2 10000
#endif
#ifndef CV_S3
#define CV_S3 3000
#endif
constexpr int CVP_1 = CVQ_C, CVP_0 = CVP_1 - CV_S1, CVP_2 = CVP_1 + CV_S2, CVP_3 = CVP_2 + CV_S3, CVP_4 = CVQ_F;
static_assert(CVP_0 >= CVQ_B && CVP_2 >= CVQ_D && CVP_3 >= CVQ_E && CVP_3 <= CVP_4, "conversion schedule: C inside the layer-0 gate/up tail, D done by the end of layer 0, E's rest fits the layer-1 in-proj tail");
__device__ __forceinline__ int cv_perm(int p) {
    if (p < CVQ_B) return p;
    if (p < CVQ_C) { const int k = p - CVQ_B; return CV_AB + (k / (2 * CV_E)) * (3 * CV_E) + (k % (2 * CV_E)); }
    if (p < CVQ_D) { const int k = p - CVQ_C; return CV_AB + (k / CV_E) * (3 * CV_E) + 2 * CV_E + (k % CV_E); }
    if (p < CVQ_E) return p;
    if (p < CVQ_F) { const int k = p - CVQ_E; return CV_LAYER + CV_AB + (k / (2 * CV_E)) * (3 * CV_E) + (k % (2 * CV_E)); }
    { const int k = p - CVQ_F; return CV_LAYER + CV_AB + (k / CV_E) * (3 * CV_E) + 2 * CV_E + (k % CV_E); }
}
__device__ __forceinline__ void convert_range(int lo, int hi, int wr_, int nw, int lane, const float* w_in, const float* w_out, const float* w_g, const float* w_u, const float* w_d, fp8_t* WinQ, bf16_t* WoutT, fp8_t* WguQ, fp8_t* WdQ) {
#define CV_DEC(i) titem_decode(cv_perm(i), w_in, w_out, w_g, w_u, w_d, WinQ, WoutT, WguQ, WdQ)
    int it = lo + wr_; if (it >= hi) return;
    TItem ta = CV_DEC(it), tb = ta; f32x4 va[16], vb[16]; titem_load(ta, lane, va);
    for (;;) {
        const int it2 = it + nw; const bool h2 = it2 < hi; if (h2) { tb = CV_DEC(it2); titem_load(tb, lane, vb); }
        titem_store(ta, lane, va);
        if (!h2) break;
        const int it3 = it2 + nw; const bool h3 = it3 < hi; if (h3) { ta = CV_DEC(it3); titem_load(ta, lane, va); }
        titem_store(tb, lane, vb);
        if (!h3) break;
        it = it3;
    }
#undef CV_DEC
}

template <bool FENCE = false, bool WF32 = false, bool WBF = true, bool WLDS = false, bool WQ = false> __device__ __forceinline__ void ln_row(f32x4 (&v)[8], const float* g, const float* b, int lane, float* outf, bf16_t* outb, LAS unsigned char* img = nullptr, int rl = 0, fp8_t* outq = nullptr) {
    asm volatile("" : "+s"(g), "+s"(b));
    float s = 0.f;
#pragma unroll
    for (int j = 0; j < 8; ++j) s += (v[j][0] + v[j][1]) + (v[j][2] + v[j][3]);
    const float mean = wave_sum(s) * (1.f / D); float s2 = 0.f;
#pragma unroll
    for (int j = 0; j < 8; ++j) { v[j] = v[j] - mean; s2 += (v[j][0] * v[j][0] + v[j][1] * v[j][1]) + (v[j][2] * v[j][2] + v[j][3] * v[j][3]); }
    const float rstd = 1.0f / sqrtf(wave_sum(s2) * (1.f / D) + LN_EPS);
#pragma unroll
    for (int j = 0; j < 8; ++j) { const f32x4 gg = *(const f32x4*)(g + 256 * j + 4 * lane), bb = *(const f32x4*)(b + 256 * j + 4 * lane);
        v[j] = v[j] * rstd * gg + bb;
        if (WF32) *(f32x4*)(outf + 256 * j + 4 * lane) = v[j];
        if (WQ) *(unsigned*)(outq + 256 * j + 4 * lane) = pk4_fp8(v[j][0], v[j][1], v[j][2], v[j][3]);
        if (WBF) { u32x2 w; w.x = cvt_pk_bf16(v[j][0], v[j][1]); w.y = cvt_pk_bf16(v[j][2], v[j][3]);
            *(u32x2*)(outb + 256 * j + 4 * lane) = w;
            if (WLDS) *(LAS u32x2*)(img + rl * 4096 + (((32 * j + (lane >> 1)) ^ rl) << 4) + (lane & 1) * 8) = w; }
        if (FENCE && (j & 1)) asm volatile("" ::: "memory"); }
}

__device__ __forceinline__ void route16(const float (&lg)[16], int& e1, int& e2, float& g1, float& g2) {
    float mx = lg[0];
#pragma unroll
    for (int e = 1; e < 16; ++e) mx = fmaxf(mx, lg[e]);
    float p[16];
#pragma unroll
    for (int e = 0; e < 16; ++e) p[e] = __builtin_amdgcn_exp2f((lg[e] - mx) * LOG2E);
    int bg = 0; float bs = -1.f;
#pragma unroll
    for (int g = 0; g < 4; ++g) { const float a = p[4 * g], b = p[4 * g + 1], c = p[4 * g + 2], d = p[4 * g + 3];
        const float h1 = fmaxf(a, b), l1 = fminf(a, b), h2 = fmaxf(c, d), l2 = fminf(c, d);
        const float s = fmaxf(h1, h2) + fmaxf(fminf(h1, h2), fmaxf(l1, l2));
        if (s > bs) { bs = s; bg = g; } }
    float q[4] = {p[0], p[1], p[2], p[3]};
#pragma unroll
    for (int g = 1; g < 4; ++g)
#pragma unroll
        for (int k = 0; k < 4; ++k) q[k] = (bg == g) ? p[4 * g + k] : q[k];
    int i1 = 0; float v1 = q[0];
#pragma unroll
    for (int k = 1; k < 4; ++k) if (q[k] > v1) { v1 = q[k]; i1 = k; }
    int i2 = 0; float v2 = -1.f;
#pragma unroll
    for (int k = 0; k < 4; ++k) if (k != i1 && q[k] > v2) { v2 = q[k]; i2 = k; }
    e1 = 4 * bg + i1; e2 = 4 * bg + i2; const float inv = 1.0f / (v1 + v2); g1 = v1 * inv; g2 = v2 * inv;
}

__global__ void __launch_bounds__(512, 2) fwd(Args a) {
    extern __shared__ __attribute__((aligned(16))) unsigned char lds_raw[];
    LAS unsigned char* lds = (LAS unsigned char*)lds_raw;
    LAS unsigned char* ldc = lds + LC_OFF;
    const int wave = __builtin_amdgcn_readfirstlane((int)threadIdx.x >> 6); const int lane = lane_id(), tid = wave * 64 + lane;
    const int G = gridDim.x; const int bx = blockIdx.x; const int vcu = (G % 8 == 0) ? (bx % 8) * (G / 8) + bx / 8 : bx;
    unsigned char* ws = a.ws;
    unsigned* ctl = (unsigned*)(ws + WS_CTL);
    for (int u = tid; u < (LDS_BYTES - LC_OFF) / 4; u += 512) ((LAS unsigned*)ldc)[u] = 0u;
    __syncthreads();
    XcdBarrier bar = xcd_barrier_post(ctl + CW_BAR, (volatile LAS unsigned*)(ldc + LC_XB), wave);

    fp8_t* WinQ = (fp8_t*)(ws + WS_WIN); bf16_t* WoutT = (bf16_t*)(ws + WS_WOUT); fp8_t* WguQ = (fp8_t*)(ws + WS_WGU); fp8_t* WdQ = (fp8_t*)(ws + WS_WD);
    bf16_t* Hb = (bf16_t*)(ws + WS_HB); bf16_t* Qb = (bf16_t*)(ws + WS_Q); bf16_t* Kb = Qb + (size_t)M * 1024; bf16_t* Vb = Kb + (size_t)M * 1024; bf16_t* Ub = Vb + (size_t)M * 1024; bf16_t* Vsb = Ub + (size_t)M * 1024;
    fp8_t* Ycat = (fp8_t*)(ws + WS_YCAT); float* vstat = (float*)(ws + WS_STAT);
    int* tok_e = (int*)(ws + WS_ROUTE); int* tok_pos = tok_e + 2 * M; float* tok_gate = (float*)(tok_pos + 2 * M); int* elist = (int*)(tok_gate + 2 * M); bf16_t* RwT = (bf16_t*)(elist + NE * M);
    fp8_t* Ybuf = (fp8_t*)(ws + WS_Y);
    fp8_t* Hq = (fp8_t*)(ws + WS_HQ); fp8_t* HidQ = (fp8_t*)(ws + WS_HID);
    float* Hf = a.out;
    const int gw = vcu * 8 + wave, NGW = G * 8;

    if (PH(0)) for (int rep_ = 0; rep_ < NREP(0); ++rep_) {
#define CONVERT(lo, hi, rank, nw) convert_range(lo, hi, rank, nw, lane, a.in[I_WIN], a.in[I_WOUT], a.in[I_WG], a.in[I_WU], a.in[I_WD], WinQ, WoutT, WguQ, WdQ)
        CONVERT(0, CVP_0, gw, NGW);
        for (int i = (vcu * 8 + wave) * 64 + lane; i < NE * D; i += NGW * 64) { const int e = i / D, k = i % D; RwT[i] = (bf16_t)(cvt_pk_bf16(a.in[I_RW][(size_t)k * NE + e], 0.f) & 0xffffu); }
        {
#define LD_X(v, m) do { const float* xr_ = a.in[I_X] + (size_t)(m) * D; _Pragma("unroll") for (int j = 0; j < 8; ++j) v[j] = __builtin_nontemporal_load((const f32x4*)(xr_ + 256 * j + 4 * lane)); } while (0)
            f32x4 va[8], vb[8]; int m = gw; if (m < M) LD_X(va, m);
            for (; m < M; m += 2 * NGW) { const int m2 = m + NGW, m3 = m2 + NGW;
                if (m2 < M) LD_X(vb, m2);
                ln_row<false, false, true, false, true>(va, a.in[I_LNG], a.in[I_LNB], lane, nullptr, Hb + (size_t)m * D, nullptr, 0, Hq + (size_t)m * D);
                if (m3 < M) LD_X(va, m3);
                if (m2 < M) ln_row<false, false, true, false, true>(vb, a.in[I_LNG], a.in[I_LNB], lane, nullptr, Hb + (size_t)m2 * D, nullptr, 0, Hq + (size_t)m2 * D); }
#undef LD_X
        }
    }
    xcd_barrier(bar);

    for (int l = 0; l < DEPTH; ++l) {
        if (PH(1)) for (int rep_ = 0; rep_ < NREP(1); ++rep_) { pg8::Gemm g{(const bf16_t*)Hq, (const bf16_t*)(WinQ + (size_t)l * NIN * D), D}; pg8::DenseOrder S{M / 256, NIN / 256, G, bx, D}; pg8::EpiIn E{Qb, vstat, 1.0f / SC_W};
          pg8::gemm_phase<pg8::EpiIn, pg8::DenseOrder, true>(lds, ldc + LC_PARK, g, S, E, wave);
          { constexpr int U = (M / 256) * (NIN / 256); const int busy = U % G;
            if (bx >= busy) { int ln2 = lane_id(); asm volatile("" : "+v"(ln2)); const int lane = ln2 & 63; const int rk = (bx - busy) * 8 + wave, nw = (G - busy) * 8;
                if (l == 0) CONVERT(CVP_0, CVP_1, rk, nw); else CONVERT(CVP_3, CVP_4, rk, nw); } } }
        xcd_barrier(bar);
        if (PH(2)) for (int rep_ = 0; rep_ < NREP(2); ++rep_) for (int u = vcu; u < NBATCH * NH * 8; u += G) { const int qb = u & 7, h = (u >> 3) & 7, b = u >> 6;
            attn_unit(lds, ldc, Qb, Kb, Vb, Ycat, a.in[I_REL] + ((size_t)l * NH + h) * NREL, b, h, qb, wave); }
        if (PH(3)) for (int rep_ = 0; rep_ < NREP(3); ++rep_) for (int u = vcu; u < NBATCH * 16 * NG; u += G) { const int g = u & 7, nb = (u >> 3) & 15, b = u >> 7;
            sgu_unit(lds, ldc, Ub, Vsb, vstat, a.in[I_SLNG] + (size_t)l * SW, a.in[I_SLNB] + (size_t)l * SW, a.in[I_SW] + ((size_t)l * NG + g) * 128 * 128, a.in[I_SB] + ((size_t)l * NG + g) * 128, Ycat, b, nb, g, wave); }
        xcd_barrier(bar);
        if (PH(4)) { pg8::Gemm g{(const bf16_t*)Ycat, (const bf16_t*)((const fp8_t*)WoutT + (size_t)l * D * D), D}; pg8::DenseOrder S{M / 256, D / 256, G, bx, D}; pg8::EpiOut E{Hb, 1.0f / (SC_W * SC_Y)};
          pg8::gemm_phase<pg8::EpiOut, pg8::DenseOrder, true>(lds, ldc + LC_PARK, g, S, E, wave); }
        xcd_barrier(bar);
        if (PH(5)) {
            int tid = TIDX(wave); asm volatile("" : "+v"(tid)); const int lane = tid & 63, r32 = lane & 31, hi = lane >> 5;
            LAS int* lcnt = (LAS int*)(ldc + LC_LCNT); LAS int* lbase = (LAS int*)(ldc + LC_LBASE);
            unsigned* gcnt = ctl + CW_CNT + 64 * l;
            const float* l1g = a.in[I_L1G] + (size_t)l * D; const float* l1b = a.in[I_L1B] + (size_t)l * D;
            for (int rb0 = vcu * 32; rb0 < M; rb0 += G * 32) {
                if (tid < 16) lcnt[tid] = 0;
                bf16x8 bw[16];
#pragma unroll
                for (int s_ = 0; s_ < 16; ++s_) { bw[s_] = (bf16x8){0, 0, 0, 0, 0, 0, 0, 0}; if (r32 < 16) bw[s_] = *(const bf16x8*)(RwT + (size_t)r32 * D + 256 * wave + 16 * s_ + 8 * hi); }
#define LD_H(v, m) do { const bf16_t* hr_ = Hb + (size_t)(m) * D; _Pragma("unroll") for (int j = 0; j < 8; ++j) v[j] = bf4_to_f32(__builtin_nontemporal_load((const u32x2*)(hr_ + 256 * j + 4 * lane))); } while (0)
                { const int mb = rb0 + wave * 4; f32x4 va[8], vb[8]; LD_H(va, mb);
#pragma unroll 1
                  for (int rp = 0; rp < 4; rp += 2) {
                    LD_H(vb, mb + rp + 1);
                    ln_row<false, false, true, true, true>(va, l1g, l1b, lane, nullptr, Hb + (size_t)(mb + rp) * D, lds, wave * 4 + rp, Hq + (size_t)(mb + rp) * D);
                    if (rp + 2 < 4) LD_H(va, mb + rp + 2);
                    ln_row<false, false, true, true, true>(vb, l1g, l1b, lane, nullptr, Hb + (size_t)(mb + rp + 1) * D, lds, wave * 4 + rp + 1, Hq + (size_t)(mb + rp + 1) * D); } }
#undef LD_H
                __syncthreads();
                f32x16 lg;
#pragma unroll
                for (int r = 0; r < 16; ++r) lg[r] = 0.f;
#pragma unroll
                for (int s_ = 0; s_ < 16; ++s_) { const bf16x8 af = *(const LAS bf16x8*)(lds + r32 * 4096 + (((32 * wave + 2 * s_ + hi) ^ r32) << 4));
                    lg = __builtin_amdgcn_mfma_f32_32x32x16_bf16(af, bw[s_], lg, 0, 0, 0); }
                __syncthreads();
                LAS float* part = (LAS float*)lds;
                if (r32 < 16) {
#pragma unroll
                    for (int r = 0; r < 16; ++r) part[(wave * 32 + crow(r, hi)) * 16 + r32] = lg[r]; }
                __syncthreads();
                int e1 = 0, e2 = 0, p1 = 0, p2 = 0; float g1 = 0.f, g2 = 0.f;
                if (tid < 32) { float a0[16];
#pragma unroll
                    for (int e = 0; e < 16; ++e) { float acc_ = a.in[I_RB][e];
#pragma unroll
                        for (int w = 0; w < 8; ++w) acc_ += part[(w * 32 + tid) * 16 + e];
                        a0[e] = acc_; }
                    route16(a0, e1, e2, g1, g2);
                    p1 = atomicAdd((int*)(lcnt + e1), 1); p2 = atomicAdd((int*)(lcnt + e2), 1); }
                __syncthreads();
                if (tid < 16) lbase[tid] = (int)__hip_atomic_fetch_add(gcnt + tid, (unsigned)lcnt[tid], __ATOMIC_RELAXED, __HIP_MEMORY_SCOPE_AGENT);
                __syncthreads();
                if (tid < 32) { const int m = rb0 + tid; p1 += lbase[e1]; p2 += lbase[e2];
                    tok_e[2 * m] = e1; tok_e[2 * m + 1] = e2; tok_pos[2 * m] = p1; tok_pos[2 * m + 1] = p2; tok_gate[2 * m] = g1; tok_gate[2 * m + 1] = g2;
                    elist[e1 * M + p1] = m; elist[e2 * M + p2] = m; }
                __syncthreads();
            }
        }
        xcd_barrier(bar);
        LAS int* ecnt = (LAS int*)(ldc + LC_ECNT); LAS int* tstart = (LAS int*)(ldc + LC_TSTART);
        { int tq = TIDX(wave); asm volatile("" : "+v"(tq));
        if (tq < 16) ecnt[tq] = (int)__hip_atomic_load(ctl + CW_CNT + 64 * l + tq, __ATOMIC_RELAXED, __HIP_MEMORY_SCOPE_AGENT);
        __syncthreads();
        if (tq == 0) { int acc = 0; for (int e = 0; e < NE; ++e) { tstart[e] = acc; acc += (ecnt[e] + 255) >> 8; } tstart[NE] = acc; }
        __syncthreads(); }
#if 0
        if (tid < 16) ecnt[tid] = (int)__hip_atomic_load(ctl + CW_CNT + 64 * l + tid, __ATOMIC_RELAXED, __HIP_MEMORY_SCOPE_AGENT);
        __syncthreads();
        if (tid == 0) { int acc = 0; for (int e = 0; e < NE; ++e) { tstart[e] = acc; acc += (ecnt[e] + 255) >> 8; } tstart[NE] = acc; }
        __syncthreads();
#endif
        const int T = tstart[NE];
        if (PH(6)) for (int rep_ = 0; rep_ < NREP(6); ++rep_) { pg8::Gemm g{(const bf16_t*)Hq, (const bf16_t*)(WguQ + (size_t)l * NE * (2 * FF) * D), D}; pg8::MoeOrder<true, true> S{T, 8, G, bx, D, 8, 0, tstart, ecnt, elist}; pg8::EpiGU E{HidQ};
          pg8::gemm_phase<pg8::EpiGU, pg8::MoeOrder<true, true>, true>(lds, ldc + LC_PARK, g, S, E, wave);
          { const int busy = (T * 8) % G; if (bx >= busy) { int ln2 = lane_id(); asm volatile("" : "+v"(ln2)); const int lane = ln2 & 63; const int rk = (bx - busy) * 8 + wave, nw = (G - busy) * 8;
              if (l == 0) CONVERT(CVP_1, CVP_2, rk, nw); else CONVERT(CVP_4, CV_TOTAL, rk, nw); } } }
        xcd_barrier(bar);
        if (PH(7)) for (int rep_ = 0; rep_ < NREP(7); ++rep_) { pg8::Gemm g{(const bf16_t*)HidQ, (const bf16_t*)(WdQ + (size_t)l * NE * D * FF), FF}; pg8::MoeOrder<false, true> S{T, 8, G, bx, FF, 8, MOE_SPLIT(l), tstart, ecnt, elist}; pg8::EpiDown E{Ybuf};
          pg8::gemm_phase<pg8::EpiDown, pg8::MoeOrder<false, true>, true>(lds, ldc + LC_PARK, g, S, E, wave);
          if (l == 0) { const int busy = (T * 8) % G; if (bx >= busy) { int ln2 = lane_id(); asm volatile("" : "+v"(ln2)); const int lane = ln2 & 63; CONVERT(CVP_2, CVP_3, (bx - busy) * 8 + wave, (G - busy) * 8); } } }
        xcd_barrier(bar);
        if (PH(8)) {
            int tid = TIDX(wave); asm volatile("" : "+v"(tid)); const int lane = tid & 63;
            const float* l2g = a.in[I_L2G] + (size_t)l * D; const float* l2b = a.in[I_L2B] + (size_t)l * D;
#define LD_R(v, ya, yb, m) do { const int e1_ = tok_e[2 * (m)], e2_ = tok_e[2 * (m) + 1]; const int s1_ = tstart[e1_] * 256 + tok_pos[2 * (m)], s2_ = tstart[e2_] * 256 + tok_pos[2 * (m) + 1]; \
                const bf16_t* hr_ = Hb + (size_t)(m) * D; const fp8_t* y1_ = Ybuf + (size_t)s1_ * D; const fp8_t* y2_ = Ybuf + (size_t)s2_ * D; \
                _Pragma("unroll") for (int j = 0; j < 8; ++j) { v[j] = bf4_to_f32(__builtin_nontemporal_load((const u32x2*)(hr_ + 256 * j + 4 * lane))); ya[j] = __builtin_nontemporal_load((const unsigned*)(y1_ + 256 * j + 4 * lane)); yb[j] = __builtin_nontemporal_load((const unsigned*)(y2_ + 256 * j + 4 * lane)); } } while (0)
#define FIN_R(v, ya, yb, m) do { const float g1_ = tok_gate[2 * (m)] * (1.0f / pg8::SC_O), g2_ = tok_gate[2 * (m) + 1] * (1.0f / pg8::SC_O); \
                _Pragma("unroll") for (int j = 0; j < 8; ++j) { const f32x2 a0_ = __builtin_amdgcn_cvt_pk_f32_fp8((int)ya[j], false), a1_ = __builtin_amdgcn_cvt_pk_f32_fp8((int)ya[j], true), b0_ = __builtin_amdgcn_cvt_pk_f32_fp8((int)yb[j], false), b1_ = __builtin_amdgcn_cvt_pk_f32_fp8((int)yb[j], true); \
                    const f32x4 t_ = {g1_ * a0_.x + g2_ * b0_.x, g1_ * a0_.y + g2_ * b0_.y, g1_ * a1_.x + g2_ * b1_.x, g1_ * a1_.y + g2_ * b1_.y}; \
                    v[j] = v[j] * ALPHA + t_; } \
                if (l + 1 < DEPTH) ln_row<true, false, true, false, true>(v, l2g, l2b, lane, nullptr, Hb + (size_t)(m) * D, nullptr, 0, Hq + (size_t)(m) * D); else ln_row<true, true, false>(v, l2g, l2b, lane, Hf + (size_t)(m) * D, nullptr); } while (0)
            if (NGW * 4 == M) {
                f32x4 va[8], vb[8]; unsigned ya1[8], ya2[8], yb1[8], yb2[8]; const int m0 = gw, m1 = gw + NGW, m2 = gw + 2 * NGW, m3 = gw + 3 * NGW;
                LD_R(va, ya1, ya2, m0); LD_R(vb, yb1, yb2, m1); FIN_R(va, ya1, ya2, m0); LD_R(va, ya1, ya2, m2); FIN_R(vb, yb1, yb2, m1); LD_R(vb, yb1, yb2, m3); FIN_R(va, ya1, ya2, m2); FIN_R(vb, yb1, yb2, m3);
            } else {
#pragma unroll 1
                for (int m = gw; m < M; m += NGW) { f32x4 va[8]; unsigned ya1[8], ya2[8]; LD_R(va, ya1, ya2, m); FIN_R(va, ya1, ya2, m); } }
#undef LD_R
#undef FIN_R
        }
        if (l + 1 < DEPTH) xcd_barrier(bar);
    }
}

extern "C" void kernel_launch(void* const* d_in, const int* in_sizes, int n_in, void* d_out, int out_size, void* d_ws, size_t ws_size, hipStream_t stream) {
    static int grid = 0;
    if (grid == 0) {
        if (n_in != 19 || out_size != M * D || ws_size < WS_END) { fprintf(stderr, "kernel_launch: unexpected shapes (n_in %d out %d ws %zu)\n", n_in, out_size, ws_size); grid = -1; return; }
        int dev = 0, cus = 0, per_cu = 0;
        if (hipGetDevice(&dev) != hipSuccess || hipDeviceGetAttribute(&cus, hipDeviceAttributeMultiprocessorCount, dev) != hipSuccess) { grid = -1; return; }
        if (hipFuncSetAttribute((const void*)fwd, hipFuncAttributeMaxDynamicSharedMemorySize, LDS_BYTES) != hipSuccess) { fprintf(stderr, "kernel_launch: hipFuncSetAttribute failed\n"); grid = -1; return; }
        if (hipOccupancyMaxActiveBlocksPerMultiprocessor(&per_cu, (const void*)fwd, 512, LDS_BYTES) != hipSuccess || per_cu < 1) { fprintf(stderr, "kernel_launch: occupancy query says %d\n", per_cu); (void)hipGetLastError(); grid = -1; return; }
        grid = cus;
    }
    if (grid < 0) return;
    (void)in_sizes;
    if (hipMemsetAsync((char*)d_ws + WS_CTL, 0, CTL_ZERO_BYTES, stream) != hipSuccess) return;
    Args a{};
    for (int i = 0; i < 19; ++i) a.in[i] = (const float*)d_in[i];
    a.out = (float*)d_out; a.ws = (unsigned char*)d_ws;
    hipLaunchKernelGGL(fwd, dim3(grid), dim3(512), LDS_BYTES, stream, a);
}
```

```cpp
#include <hip/hip_runtime.h>
#include <cstdio>

#define LAS __attribute__((address_space(3)))
#define GAS __attribute__((address_space(1)))
typedef unsigned short bf16_t;
typedef short bf16x8 __attribute__((ext_vector_type(8)));
typedef short s16x4 __attribute__((ext_vector_type(4)));
typedef float f32x2 __attribute__((ext_vector_type(2)));
typedef float f32x4 __attribute__((ext_vector_type(4)));
typedef float f32x16 __attribute__((ext_vector_type(16)));
typedef unsigned u32x2 __attribute__((ext_vector_type(2)));
typedef unsigned u32x4 __attribute__((ext_vector_type(4)));
typedef int v8i __attribute__((ext_vector_type(8)));
template <bool Q8> struct Frag;
template <> struct Frag<false> { bf16x8 k[2]; };
template <> struct Frag<true> { v8i q; };
typedef unsigned char fp8_t;

constexpr int M = 8192, D = 2048, SEQ = 2048, NBATCH = 4, DEPTH = 2;
constexpr int AW = 1024, NH = 8, HD = 128, SW = 1024, NG = 8, NIN = 5120, FF = 1024, NE = 16;
constexpr int NREL = 257;
constexpr float LN_EPS = 1e-5f;
constexpr float ALPHA = 1.4142135623730951f;
constexpr float LOG2E = 1.4426950408889634f;
constexpr float QSCALE = 0.08838834764831845f * LOG2E;
constexpr int MPAD = 20480;

constexpr size_t MiB = 1u << 20;
constexpr size_t WS_CTL = 0, CTL_ZERO_BYTES = 128 * 1024;
constexpr size_t WS_WIN = 1 * MiB;
constexpr size_t WS_WOUT = 41 * MiB;
constexpr size_t WS_WGU = 57 * MiB;
constexpr size_t WS_WD = 313 * MiB;
constexpr size_t WS_HB = 441 * MiB;
constexpr size_t WS_Q = 473 * MiB;
constexpr size_t WS_YCAT = 553 * MiB;
constexpr size_t WS_STAT = 585 * MiB;
constexpr size_t WS_ROUTE = 586 * MiB;
constexpr size_t WS_HID = 588 * MiB;
constexpr size_t WS_Y = 628 * MiB;
constexpr size_t WS_HQ = 708 * MiB;
constexpr size_t WS_END = 724 * MiB;
constexpr int CW_BAR = 4096, CW_CNT = 16384;

constexpr int RING_BYTES = 131072;
constexpr int LC_OFF = RING_BYTES;
constexpr int LC_XB = 0, LC_LCNT = 64, LC_LBASE = 128, LC_ECNT = 192, LC_TSTART = 256, LC_ROWINFO = 512, LC_SGUST = 2048, LC_PARK = 4096;
constexpr int LDS_BYTES = 147456;

__device__ __forceinline__ unsigned cvt_pk_bf16(float lo, float hi) { unsigned r; asm volatile("v_cvt_pk_bf16_f32 %0, %1, %2" : "=v"(r) : "v"(lo), "v"(hi)); return r; }
__device__ __forceinline__ unsigned pk4_fp8(float a, float b, float c, float d) { int w = 0; w = __builtin_amdgcn_cvt_pk_fp8_f32(a, b, w, false); w = __builtin_amdgcn_cvt_pk_fp8_f32(c, d, w, true); return (unsigned)w; }
__device__ __forceinline__ fp8_t f2fp8(float x) { return (fp8_t)(__builtin_amdgcn_cvt_pk_fp8_f32(x, x, 0, false) & 0xff); }
constexpr float SC_Y = 16.0f;
constexpr float SC_W = 128.0f;
__device__ __forceinline__ float bf2f(unsigned short x) { return __uint_as_float(((unsigned)x) << 16); }
__device__ __forceinline__ f32x4 bf4_to_f32(u32x2 w) { return (f32x4){__uint_as_float(w.x << 16), __uint_as_float(w.x & 0xffff0000u), __uint_as_float(w.y << 16), __uint_as_float(w.y & 0xffff0000u)}; }
__device__ __forceinline__ float wave_sum(float v) {
#pragma unroll
    for (int o = 1; o < 64; o <<= 1) v += __shfl_xor(v, o);
    return v;
}
__device__ __forceinline__ int lane_id() { int l_; asm volatile("v_mbcnt_lo_u32_b32 %0, -1, 0\n\tv_mbcnt_hi_u32_b32 %0, -1, %0" : "=v"(l_)); return l_; }
#define TIDX(wv) ((wv) * 64 + lane_id())
#define LDS_WAIT() asm volatile("s_waitcnt lgkmcnt(0)" ::: "memory")
#define VM_WAIT() asm volatile("s_waitcnt vmcnt(0)" ::: "memory")
#define SBAR() __builtin_amdgcn_sched_barrier(0)

#define XB_TMO      128
#define XB_XCNT(j)  (256  + 64 * (j))
#define XB_XSUB(j)  (1280 + 64 * (j))
#define XB_XGEN(j)  (2304 + 64 * (j))
#define XB_TOP      3328
#define XB_TOPGEN   3392
#define XCD_BAR_WORDS 3456
#define XB_SPIN_CAP (1u << 18)
__device__ __forceinline__ unsigned xb_ld(unsigned* p)              { return __hip_atomic_load(p, __ATOMIC_RELAXED, __HIP_MEMORY_SCOPE_AGENT); }
__device__ __forceinline__ unsigned xb_add(unsigned* p, unsigned v) { return __hip_atomic_fetch_add(p, v, __ATOMIC_RELAXED, __HIP_MEMORY_SCOPE_AGENT); }
__device__ __forceinline__ unsigned xb_xcc_id() { return (unsigned)__builtin_amdgcn_s_getreg((3 << 11) | 20) & 0xFu; }
#define XB_SPIN(cond, bar) do { unsigned _sp = 0; while (cond) { __builtin_amdgcn_s_sleep(1); \
    if ((++_sp & 255u) == 0u) { if (xb_ld(&(bar)[XB_TMO])) break; if (_sp > XB_SPIN_CAP) { atomicAdd(&(bar)[XB_TMO], 1u); break; } } } } while (0)
struct XcdBarrier { unsigned* bar; unsigned x; volatile LAS unsigned* st; int wv; };
__device__ __forceinline__ XcdBarrier xcd_barrier_post(unsigned* bar, volatile LAS unsigned* st, int wv) {
    XcdBarrier b; b.bar = bar; b.x = xb_xcc_id(); b.st = st; b.wv = wv;
    if (TIDX(wv) == 0) (void)xb_add(&bar[XB_XCNT(b.x)], 1u);
    return b;
}
__device__ __forceinline__ void xcd_barrier_complete(unsigned* bar, unsigned x, unsigned& nloc, unsigned& nx) {
    const unsigned G = gridDim.x * gridDim.y * gridDim.z;
    unsigned sum, cnt, mine, sp = 0u;
    for (;;) {
        sum = 0u; cnt = 0u; mine = 0u;
#pragma unroll
        for (unsigned j = 0; j < 16; ++j) { const unsigned c = xb_ld(&bar[XB_XCNT(j)]); sum += c; cnt += (c > 0u) ? 1u : 0u; mine = (j == x) ? c : mine; }
        if (sum == G) break;
        __builtin_amdgcn_s_sleep(1);
        if ((++sp & 255u) == 0u) { if (xb_ld(&bar[XB_TMO])) break; if (sp > XB_SPIN_CAP) { atomicAdd(&bar[XB_TMO], 1u); break; } }
    }
    nloc = mine > 0u ? mine : 1u; nx = cnt > 0u ? cnt : 1u;
}
__device__ __forceinline__ void xcd_barrier(const XcdBarrier& b) {
    asm volatile("s_waitcnt vmcnt(0)" ::: "memory");
    __syncthreads();
    if (TIDX(b.wv) == 0) {
        unsigned* bar = b.bar; const unsigned bx_ = xb_xcc_id();
        __builtin_amdgcn_s_waitcnt(0);
        unsigned nloc = b.st[0], nx = b.st[1];
        if (nloc == 0u) { xcd_barrier_complete(bar, bx_, nloc, nx); b.st[0] = nloc; b.st[1] = nx; }
        const unsigned old = xb_add(&bar[XB_XSUB(bx_)], 1u);
        const unsigned gen = old / nloc;
        if (old + 1u == (gen + 1u) * nloc) {
            __builtin_amdgcn_fence(__ATOMIC_RELEASE, "agent");
            asm volatile("s_waitcnt vmcnt(0)" ::: "memory");
            const unsigned og = xb_add(&bar[XB_TOP], 1u);
            const unsigned tg = og / nx;
            if (og + 1u == (tg + 1u) * nx) xb_add(&bar[XB_TOPGEN], 1u);
            else XB_SPIN(xb_ld(&bar[XB_TOPGEN]) == tg, bar);
            __builtin_amdgcn_fence(__ATOMIC_ACQUIRE, "agent");
            xb_add(&bar[XB_XGEN(bx_)], 1u);
            asm volatile("s_waitcnt vmcnt(0)" ::: "memory");
        } else {
            XB_SPIN(xb_ld(&bar[XB_XGEN(bx_)]) == gen, bar);
            __builtin_amdgcn_fence(__ATOMIC_ACQUIRE, "agent");
            asm volatile("s_waitcnt vmcnt(0)" ::: "memory");
        }
    }
    __syncthreads();
}

namespace pg8 {
constexpr int BM = 256, BK = 64, HALF = 128, HTB = HALF * BK * 2, STAGE_BYTES = 8 * HTB, NXCD = 8, WGM = 8;
__host__ __device__ __forceinline__ int lds_byte(int r, int c) { const int st = (r >> 4) * 2 + (c >> 5), rr = r & 15, cc = c & 31, ob = rr * 64 + cc * 2; return st * 1024 + (ob ^ (((ob >> 9) & 1) << 5)); }
__host__ __device__ __forceinline__ void stage_rc(int b, int& R, int& C) { const int st = b / 1024, sb = b % 1024, swz = sb ^ (((sb >> 9) & 1) << 5); R = (st >> 1) * 16 + swz / 64; C = (st & 1) * 32 + (swz % 64) / 2; }
__host__ __device__ __forceinline__ int gray2(int b) { return b ^ (b >> 1); }
__host__ __device__ __forceinline__ void stage_rc8(int b, int& R, int& Cb) { const int st = b / 1024, w = b % 1024, rr = w / 64, p = (w % 64) / 16; R = (st >> 1) * 16 + rr; Cb = (st & 1) * 64 + (p ^ gray2(rr >> 2)) * 16; }
__host__ __device__ __forceinline__ int frag_off8(int row, int fq, int second) { const int rr = row & 15, c = 2 * (fq & 1) + second; return ((row >> 4) * 2 + (fq >> 1)) * 1024 + rr * 64 + ((c ^ gray2(rr >> 2)) * 16); }
__host__ __device__ __forceinline__ int perm32(int rho) { const int n = rho >> 4, i = rho & 15; return 8 * (i >> 2) + 4 * n + (i & 3); }

struct Unit { int pm, pn, pb, rel0, cnt, lb, half; };
struct Gemm { const bf16_t* A; const bf16_t* Bt; int K; };

__device__ __forceinline__ void order_map(int nM, int nN, int L, int& pm, int& pn) {
    const int nwg = nM * nN;
    int wgid = L; { const int q = nwg / NXCD, r = nwg % NXCD, xcd = wgid % NXCD, off = wgid / NXCD; wgid = (xcd < r ? xcd * (q + 1) : r * (q + 1) + (xcd - r) * q) + off; }
    const int nig = WGM * nN, gid = wgid / nig, fm = gid * WGM, gsz = (nM - fm) < WGM ? (nM - fm) : WGM;
    pm = fm + ((wgid % nig) % gsz); pn = (wgid % nig) / gsz;
}
struct DenseOrder {
    static constexpr bool GATHER = false;
    int nM, nN, G, c, K;
    __device__ __forceinline__ bool next(int i, Unit& u) const { const long L = (long)i * G + c; if (L >= nM * nN) return false; int pm, pn; order_map(nM, nN, (int)L, pm, pn);
        u.pm = pm; u.pn = pn; u.pb = pn; u.rel0 = 0; u.cnt = 0; u.lb = 0; u.half = 0; return true; }
    __device__ __forceinline__ void a_off(const Unit&, int, unsigned (&)[2][2]) const {}
};
template <bool GATHER_, bool Q8_ = false> struct MoeOrder {
    static constexpr bool GATHER = GATHER_;
    int nM, nN, G, c, K, tpe, split;
    const LAS int* tstart; const LAS int* ecnt; const int* list;
    __device__ __forceinline__ bool next(int i, Unit& u) const {
        const int U = nM * nN, R = U % G; const bool sp = split && R > 0 && 2 * R <= G;
        const long L = (long)i * G + c; if (L >= (sp ? U + R : U)) return false;
        int base = (int)L, half = 0;
        if (sp && L >= U - R) { const int Lp = (int)L - (U - R); base = (U - R) + (Lp >> 1); half = 1 + (Lp & 1); }
        int pm, pn; order_map(nM, nN, base, pm, pn);
        int e = 0;
#pragma unroll
        for (int k = 1; k < NE; ++k) e = (pm >= tstart[k]) ? k : e;
        u.pm = pm; u.pn = pn; u.pb = e * tpe + pn; u.rel0 = (pm - tstart[e]) * BM; u.cnt = ecnt[e]; u.lb = e * M; u.half = half; return true;
    }
    __device__ __forceinline__ void a_off(const Unit& u, int tid, unsigned (&vo)[2][2]) const {
        asm volatile("" : "+v"(tid));
#pragma unroll
        for (int i = 0; i < 2; ++i) { int R, Cb; if (Q8_) stage_rc8(tid * 16 + i * 8192, R, Cb); else { int C; stage_rc(tid * 16 + i * 8192, R, C); Cb = 2 * C; }
#pragma unroll
            for (int h = 0; h < 2; ++h) { const int rel = u.rel0 + (u.half == 2 ? HALF : 0) + (u.half ? 0 : h * HALF) + R; const int tok = rel < u.cnt ? list[u.lb + rel] : 0; vo[h][i] = (unsigned)(tok * K * (Q8_ ? 1 : 2) + Cb); } }
        asm volatile("s_waitcnt vmcnt(0)" ::: "memory");
    }
};

__device__ __forceinline__ f32x2 gelu_pk(f32x2 v) {
    const f32x2 av = __builtin_elementwise_abs(v), d = av * 0.2316418882f + 1.0f;
    f32x2 t; t.x = __builtin_amdgcn_rcpf(d.x); t.y = __builtin_amdgcn_rcpf(d.y);
    f32x2 q = t * 0.5307027145f + (-0.7265760135f); q = q * t + 0.7107068705f; q = q * t + (-0.142248368f); q = q * t + 0.127414796f; q = q * t;
    const f32x2 s = (v * v) * (-0.72134752044f);
    f32x2 e; e.x = __builtin_amdgcn_exp2f(s.x); e.y = __builtin_amdgcn_exp2f(s.y);
    const f32x2 t2 = av * (q * e);
    f32x2 o; o.x = fmaxf(v.x, 0.f) - t2.x; o.y = fmaxf(v.y, 0.f) - t2.y; return o;
}
__device__ __forceinline__ f32x4 gelu4(f32x4 v) { const f32x2 a = gelu_pk((f32x2){v[0], v[1]}), b = gelu_pk((f32x2){v[2], v[3]}); return (f32x4){a.x, a.y, b.x, b.y}; }
__device__ __forceinline__ float silu1(float x) { return x * __builtin_amdgcn_rcpf(1.0f + __builtin_amdgcn_exp2f(-x * LOG2E)); }

struct EpiIn {
    static constexpr bool PERM = true;
    bf16_t* Q; float* vstat; float oscale;
    __device__ __forceinline__ void operator()(const f32x4 (&acc)[2][2][4][2], const Unit& u, int wr, int wc, int fr, int fq) const {
        const int region = u.pn >> 2, ct = (u.pn & 3) * BM;
        bf16_t* base = Q + (size_t)region * ((size_t)M * 1024);
        const int row0 = u.pm * BM + (u.half == 2 ? HALF : 0) + wr * 64 + fr, col0 = ct + wc * 32 + 8 * fq; const int nai = u.half ? 1 : 2;
        const float sc = region == 0 ? QSCALE : 1.0f;
        const float os = oscale;
#pragma unroll
        for (int ai = 0; ai < 2; ++ai) if (ai < nai)
#pragma unroll
            for (int m = 0; m < 4; ++m) { const int row = row0 + ai * HALF + m * 16; bf16_t* rowp = base + (size_t)row * 1024 + col0; float s1 = 0.f, s2 = 0.f;
#pragma unroll
                for (int bj = 0; bj < 2; ++bj) { f32x4 v0 = acc[ai][bj][m][0] * os, v1 = acc[ai][bj][m][1] * os;
                    if (region >= 3) { v0 = gelu4(v0); v1 = gelu4(v1); }
                    if (region == 4) { s1 += (v0[0] + v0[1]) + (v0[2] + v0[3]) + (v1[0] + v1[1]) + (v1[2] + v1[3]);
                        s2 += (v0[0] * v0[0] + v0[1] * v0[1]) + (v0[2] * v0[2] + v0[3] * v0[3]) + (v1[0] * v1[0] + v1[1] * v1[1]) + (v1[2] * v1[2] + v1[3] * v1[3]); }
                    v0 = v0 * sc; v1 = v1 * sc; u32x4 w; w.x = cvt_pk_bf16(v0[0], v0[1]); w.y = cvt_pk_bf16(v0[2], v0[3]); w.z = cvt_pk_bf16(v1[0], v1[1]); w.w = cvt_pk_bf16(v1[2], v1[3]);
                    *(u32x4*)(rowp + bj * HALF) = w; }
                if (region == 4) { s1 += __shfl_xor(s1, 16); s1 += __shfl_xor(s1, 32); s2 += __shfl_xor(s2, 16); s2 += __shfl_xor(s2, 32);
                    if (fq == 0) *(f32x2*)(vstat + ((size_t)row * 16 + (u.pn & 3) * 4 + wc) * 2) = (f32x2){s1, s2}; } }
    }
};
struct EpiOut {
    static constexpr bool PERM = true;
    bf16_t* H; float oscale;
    __device__ __forceinline__ void operator()(const f32x4 (&acc)[2][2][4][2], const Unit& u, int wr, int wc, int fr, int fq) const {
        const int row0 = u.pm * BM + (u.half == 2 ? HALF : 0) + wr * 64 + fr, col0 = u.pn * BM + wc * 32 + 8 * fq; const int nai = u.half ? 1 : 2;
#pragma unroll
        for (int ai = 0; ai < 2; ++ai) if (ai < nai)
#pragma unroll
            for (int m = 0; m < 4; ++m) { bf16_t* rowp = H + (size_t)(row0 + ai * HALF + m * 16) * D + col0;
                u32x4 hv[2];
#pragma unroll
                for (int bj = 0; bj < 2; ++bj) hv[bj] = *(const u32x4*)(rowp + bj * HALF);
#pragma unroll
                for (int bj = 0; bj < 2; ++bj) { const f32x4 h0 = bf4_to_f32((u32x2){hv[bj].x, hv[bj].y}), h1 = bf4_to_f32((u32x2){hv[bj].z, hv[bj].w});
                    const f32x4 v0 = h0 * ALPHA + acc[ai][bj][m][0] * oscale, v1 = h1 * ALPHA + acc[ai][bj][m][1] * oscale;
                    u32x4 w; w.x = cvt_pk_bf16(v0[0], v0[1]); w.y = cvt_pk_bf16(v0[2], v0[3]); w.z = cvt_pk_bf16(v1[0], v1[1]); w.w = cvt_pk_bf16(v1[2], v1[3]);
                    *(u32x4*)(rowp + bj * HALF) = w; } }
    }
};
constexpr float SC_H = 16.0f, SC_O = 64.0f;
struct EpiGU {
    static constexpr bool PERM = true;
    fp8_t* Hid;
    __device__ __forceinline__ void operator()(const f32x4 (&acc)[2][2][4][2], const Unit& u, int wr, int wc, int fr, int fq) const {
        const int row0 = u.pm * BM + (u.half == 2 ? HALF : 0) + wr * 64 + fr, col0 = u.pn * HALF + wc * 32 + 8 * fq; const int nai = u.half ? 1 : 2;
#pragma unroll
        for (int ai = 0; ai < 2; ++ai) if (ai < nai)
#pragma unroll
            for (int m = 0; m < 4; ++m) { fp8_t* rowp = Hid + (size_t)(row0 + ai * HALF + m * 16) * FF + col0;
                const f32x4 g0 = acc[ai][0][m][0] * (1.0f / SC_W), g1 = acc[ai][0][m][1] * (1.0f / SC_W), u0 = acc[ai][1][m][0] * (SC_H / SC_W), u1 = acc[ai][1][m][1] * (SC_H / SC_W);
                float h[8];
#pragma unroll
                for (int j = 0; j < 4; ++j) { h[j] = silu1(g0[j]) * u0[j]; h[4 + j] = silu1(g1[j]) * u1[j]; }
                u32x2 w; w.x = pk4_fp8(h[0], h[1], h[2], h[3]); w.y = pk4_fp8(h[4], h[5], h[6], h[7]);
                *(u32x2*)rowp = w; }
    }
};
struct EpiDown {
    static constexpr bool PERM = true;
    fp8_t* Y;
    __device__ __forceinline__ void operator()(const f32x4 (&acc)[2][2][4][2], const Unit& u, int wr, int wc, int fr, int fq) const {
        const int row0 = u.pm * BM + (u.half == 2 ? HALF : 0) + wr * 64 + fr, col0 = u.pn * BM + wc * 32 + 8 * fq; const int nai = u.half ? 1 : 2;
        constexpr float os = SC_O / (SC_W * SC_H);
#pragma unroll
        for (int ai = 0; ai < 2; ++ai) if (ai < nai)
#pragma unroll
            for (int m = 0; m < 4; ++m) { fp8_t* rowp = Y + (size_t)(row0 + ai * HALF + m * 16) * D + col0;
#pragma unroll
                for (int bj = 0; bj < 2; ++bj) { const f32x4 v0 = acc[ai][bj][m][0] * os, v1 = acc[ai][bj][m][1] * os;
                    u32x2 w; w.x = pk4_fp8(v0[0], v0[1], v0[2], v0[3]); w.y = pk4_fp8(v1[0], v1[1], v1[2], v1[3]);
                    *(u32x2*)(rowp + bj * HALF) = w; } }
    }
};

template <class Epi, class Sched, bool Q8 = false>
__device__ __forceinline__ void gemm_phase(LAS unsigned char* lds, LAS unsigned char* park, const Gemm g, const Sched& S, const Epi& E, int wv) {
    int tid = TIDX(wv); asm volatile("" : "+v"(tid));
    const int wid = __builtin_amdgcn_readfirstlane(tid >> 6), lane = tid & 63, wr = wid >> 2, wc = wid & 3, fr = lane & 15, fq = lane >> 4;
    constexpr bool GA = Sched::GATHER;
    constexpr int ESZ = Q8 ? 1 : 2;
    const int K = g.K, nt = K * ESZ / 128;
    unsigned voffA[2], voffB[2];
#pragma unroll
    for (int i = 0; i < 2; ++i) { int R, Cb; if (Q8) stage_rc8(tid * 16 + i * 8192, R, Cb); else { int C; stage_rc(tid * 16 + i * 8192, R, C); Cb = 2 * C; }
        const int Rb = Epi::PERM ? ((R & ~31) + perm32(R & 31)) : R; voffA[i] = (unsigned)(R * K * ESZ + Cb); voffB[i] = (unsigned)(Rb * K * ESZ + Cb); }
    const size_t kstep = (size_t)128;
    const size_t hstep = (size_t)HALF * K * ESZ;
    const size_t tstep = 2 * hstep;
    const unsigned ldsw = (unsigned)wid * 1024u;
    const int aoff = Q8 ? frag_off8(wr * 64 + fr, fq, 0) : lds_byte(wr * 64 + fr, fq * 8), boff = Q8 ? frag_off8(wc * 32 + fr, fq, 0) : lds_byte(wc * 32 + fr, fq * 8);
    const int aoff1 = Q8 ? frag_off8(wr * 64 + fr, fq, 1) : aoff + 1024;
    int boffh = boff + 65536; asm volatile("" : "+v"(boffh));
    int boffh1 = (Q8 ? frag_off8(wc * 32 + fr, fq, 1) : boff + 1024) + 65536; asm volatile("" : "+v"(boffh1));
#define PG8_SA(b, h) (((b) * 2 + (h)) * HTB)
#define PG8_SB(b, h) ((4 + (b) * 2 + (h)) * HTB)
#define PG8_STAGE(bufoff, gbase, voff) do { _Pragma("unroll") for (int _i = 0; _i < 2; ++_i) \
        __builtin_amdgcn_global_load_lds((const unsigned*)((const char*)(gbase) + (voff)[_i]), (LAS unsigned*)(lds + (bufoff) + ldsw + _i * 8192), 16, 0, 0); } while (0)
#define PG8_STAGE_A(bufoff, h, ap, hs, kb) do { if constexpr (GA) { _Pragma("unroll") for (int _i = 0; _i < 2; ++_i) \
        __builtin_amdgcn_global_load_lds((const unsigned*)(Abase + (kb) + vc[h][_i]), (LAS unsigned*)(lds + (bufoff) + ldsw + _i * 8192), 16, 0, 0); } \
        else PG8_STAGE(bufoff, (ap) + ((h) ? (hs) : (size_t)0) + (kb), voffA); } while (0)
#define PG8_LDF(dst, base0, base1) do { if constexpr (Q8) { const u32x4 lo_ = *(const LAS u32x4*)(lds + (base0)), hi_ = *(const LAS u32x4*)(lds + (base1)); \
        dst.q = __builtin_bit_cast(v8i, __builtin_shufflevector(lo_, hi_, 0, 1, 2, 3, 4, 5, 6, 7)); } \
        else { dst.k[0] = *(const LAS bf16x8*)(lds + (base0)); dst.k[1] = *(const LAS bf16x8*)(lds + (base1)); } } while (0)
#define PG8_LDA(dst, b, h) do { _Pragma("unroll") for (int m = 0; m < 4; ++m) PG8_LDF(dst[m], PG8_SA(b, h) + aoff + m * 2048, PG8_SA(b, h) + aoff1 + m * 2048); } while (0)
#define PG8_LDB(dst, b, h) do { _Pragma("unroll") for (int n = 0; n < 2; ++n) PG8_LDF(dst[n], (PG8_SB(b, h) - 65536) + boffh + n * 2048, (PG8_SB(b, h) - 65536) + boffh1 + n * 2048); } while (0)
#define PG8_MMA(ai, bj, At, Bt) do { __builtin_amdgcn_s_setprio(1); if constexpr (Q8) { _Pragma("unroll") for (int m = 0; m < 4; ++m) _Pragma("unroll") for (int n = 0; n < 2; ++n) \
        asm volatile("v_mfma_scale_f32_16x16x128_f8f6f4 %0, %1, %2, %0, %3, %3 op_sel_hi:[0,0,0]" : "+v"(acc[ai][bj][m][n]) : "v"(Bt[n].q), "v"(At[m].q), "v"(qscale)); } \
        else { _Pragma("unroll") for (int m = 0; m < 4; ++m) _Pragma("unroll") for (int n = 0; n < 2; ++n) _Pragma("unroll") for (int k = 0; k < 2; ++k) \
        acc[ai][bj][m][n] = __builtin_amdgcn_mfma_f32_16x16x32_bf16(Bt[n].k[k], At[m].k[k], acc[ai][bj][m][n], 0, 0, 0); } __builtin_amdgcn_s_setprio(0); } while (0)
#define PG8_WAIT_V(n) asm volatile("s_waitcnt vmcnt(" #n ")" ::: "memory")
#define PG8_WAIT_L(n) asm volatile("s_waitcnt lgkmcnt(" #n ")" ::: "memory")
#define PG8_BAR __builtin_amdgcn_s_barrier()
#define PG8_SCHED __builtin_amdgcn_sched_barrier(0)
    Unit cur, nxt; int ui = 0;
    if (!S.next(0, cur)) return;
    f32x4 acc[2][2][4][2];
#pragma unroll
    for (int a = 0; a < 2; ++a)
#pragma unroll
        for (int b = 0; b < 2; ++b)
#pragma unroll
            for (int m = 0; m < 4; ++m)
#pragma unroll
                for (int n = 0; n < 2; ++n) acc[a][b][m][n] = (f32x4){0.f, 0.f, 0.f, 0.f};
    Frag<Q8> At[4], B0[2], B1[2];
    int qscale = 0x7f7f7f7f; if constexpr (Q8) asm volatile("" : "+v"(qscale));
    unsigned vc[2][2];
    LAS u32x4* const mypark = (LAS u32x4*)(park + tid * 16);
    if constexpr (GA) S.a_off(cur, tid, vc);
    const char* const Abase = (const char*)g.A;
    const char* cA = Abase + (size_t)cur.pm * tstep + (cur.half == 2 ? hstep : (size_t)0); size_t chs = cur.half ? (size_t)0 : hstep;
    const char* cB = (const char*)g.Bt + (size_t)cur.pb * tstep;
    PG8_STAGE(PG8_SB(0, 0), cB, voffB); PG8_STAGE(PG8_SB(0, 1), cB + hstep, voffB); PG8_STAGE_A(PG8_SA(0, 0), 0, cA, chs, 0); PG8_STAGE_A(PG8_SA(0, 1), 1, cA, chs, 0);
    if (wr == 1) PG8_BAR;
    PG8_WAIT_V(2); PG8_BAR;
    PG8_STAGE(PG8_SB(1, 0), cB + kstep, voffB); PG8_STAGE_A(PG8_SA(1, 0), 0, cA, chs, kstep); PG8_STAGE(PG8_SB(1, 1), cB + hstep + kstep, voffB);
    PG8_WAIT_V(6); PG8_BAR;
    for (;;) {
        const bool has_next = S.next(ui + 1, nxt);
        if constexpr (GA) { if (has_next) { unsigned vn[2][2]; S.a_off(nxt, tid, vn); *mypark = (u32x4){vn[0][0], vn[0][1], vn[1][0], vn[1][1]}; } }
        const char* nA = has_next ? Abase + (size_t)nxt.pm * tstep + (nxt.half == 2 ? hstep : (size_t)0) : cA; const size_t nhs = has_next ? (nxt.half ? (size_t)0 : hstep) : chs;
        const bool full = cur.half == 0;
        const char* nB = has_next ? (const char*)g.Bt + (size_t)nxt.pb * tstep : cB;
        for (int t = 0; t < nt; t += 2) {
            const bool last = (t == nt - 2);
            const size_t ka1 = (size_t)(t + 1) * kstep;
            const size_t ka2 = last ? (size_t)0 : (size_t)(t + 2) * kstep, ka3 = ka2 + kstep;
            const char* a2 = last ? nA : cA; const size_t hs2 = last ? nhs : chs;
            const char* b2 = last ? nB : cB + (size_t)(t + 2) * kstep; const char* b3 = b2 + kstep;
            PG8_LDB(B0, 0, 0); PG8_LDB(B1, 0, 1); PG8_SCHED; PG8_LDA(At, 0, 0); PG8_STAGE_A(PG8_SA(1, 1), 1, cA, chs, ka1);
            PG8_WAIT_V(8); PG8_WAIT_L(0); PG8_BAR; PG8_MMA(0, 0, At, B0); PG8_MMA(0, 1, At, B1); PG8_BAR; PG8_SCHED;
            if constexpr (GA) { if (last && has_next) { const u32x4 pv = *mypark; vc[0][0] = pv.x; vc[0][1] = pv.y; vc[1][0] = pv.z; vc[1][1] = pv.w; } }
            if (full) PG8_LDA(At, 0, 1); PG8_STAGE(PG8_SB(0, 0), b2, voffB); PG8_STAGE(PG8_SB(0, 1), b2 + hstep, voffB); PG8_STAGE_A(PG8_SA(0, 0), 0, a2, hs2, ka2);
            PG8_WAIT_V(8); PG8_WAIT_L(0); PG8_BAR; if (full) { PG8_MMA(1, 0, At, B0); PG8_MMA(1, 1, At, B1); } PG8_BAR; PG8_SCHED;
            PG8_LDB(B0, 1, 0); PG8_LDB(B1, 1, 1); PG8_SCHED; PG8_LDA(At, 1, 0); PG8_STAGE_A(PG8_SA(0, 1), 1, a2, hs2, ka2);
            PG8_WAIT_V(8); PG8_WAIT_L(0); PG8_BAR; PG8_MMA(0, 0, At, B0); PG8_MMA(0, 1, At, B1); PG8_BAR; PG8_SCHED;
            if (full) PG8_LDA(At, 1, 1); PG8_STAGE(PG8_SB(1, 0), b3, voffB); PG8_STAGE(PG8_SB(1, 1), b3 + hstep, voffB); PG8_STAGE_A(PG8_SA(1, 0), 0, a2, hs2, ka3);
            PG8_WAIT_V(8); PG8_WAIT_L(0); PG8_BAR; if (full) { PG8_MMA(1, 0, At, B0); PG8_MMA(1, 1, At, B1); } PG8_BAR; PG8_SCHED;
        }
        if (wr == 0) PG8_BAR;
        if constexpr (Q8) asm volatile("s_nop 15\n\ts_nop 15" ::: "memory");
        E(acc, cur, wr, wc, fr, fq);
        if (!has_next) break;
#pragma unroll
        for (int a = 0; a < 2; ++a)
#pragma unroll
            for (int b = 0; b < 2; ++b)
#pragma unroll
                for (int m = 0; m < 4; ++m)
#pragma unroll
                    for (int n = 0; n < 2; ++n) acc[a][b][m][n] = (f32x4){0.f, 0.f, 0.f, 0.f};
        cur = nxt; cA = nA; cB = nB; chs = nhs; ++ui;
        if (wr == 1) PG8_BAR;
    }
    PG8_WAIT_V(0);
    PG8_BAR;
#undef PG8_SA
#undef PG8_SB
#undef PG8_STAGE
#undef PG8_STAGE_A
#undef PG8_LDA
#undef PG8_LDB
#undef PG8_MMA
#undef PG8_WAIT_V
#undef PG8_WAIT_L
#undef PG8_BAR
#undef PG8_SCHED
}
}

#define KSWZ(row, colB) ((row) * 256 + ((colB) ^ (((row) & 7) << 4)))
__device__ __forceinline__ int crow(int r, int hi) { return (r & 3) + 8 * (r >> 2) + 4 * hi; }
__device__ __forceinline__ int v_st(int k, int c) { const int kk = (k & ~0xC) | ((k & 4) << 1) | ((k & 8) >> 1); return ((kk >> 3) * 4 + (c >> 5)) * 512 + ((kk & 7) * 32 + (c & 31)) * 2; }
__device__ __forceinline__ int v_rd_base(int lane) { return ((lane & 3) << 3) | (((lane >> 2) & 3) << 6) | (((lane >> 4) & 1) << 5) | (((lane >> 5) & 1) << 8); }
constexpr int v_rd_off(int d0, int ks, int half) { return d0 * 512 + ks * 4096 + half * 2048; }
template <int OFF> __device__ __forceinline__ s16x4 tr_read(unsigned vb) {
    s16x4 r; asm volatile("ds_read_b64_tr_b16 %0, %1 offset:%2" : "=&v"(r) : "v"(vb), "i"(OFF) : "memory"); return r;
}
#define PKF(L, H) (bf16x8){L[0], L[1], L[2], L[3], H[0], H[1], H[2], H[3]}
template <int D0> __device__ __forceinline__ void pv_one(f32x16& od, unsigned vb, bf16x8 pa0, bf16x8 pa1, bf16x8 pa2, bf16x8 pa3) {
    const s16x4 l0 = tr_read<v_rd_off(D0, 0, 0)>(vb), h0 = tr_read<v_rd_off(D0, 0, 1)>(vb), l1 = tr_read<v_rd_off(D0, 1, 0)>(vb), h1 = tr_read<v_rd_off(D0, 1, 1)>(vb);
    const s16x4 l2 = tr_read<v_rd_off(D0, 2, 0)>(vb), h2 = tr_read<v_rd_off(D0, 2, 1)>(vb), l3 = tr_read<v_rd_off(D0, 3, 0)>(vb), h3 = tr_read<v_rd_off(D0, 3, 1)>(vb);
    asm volatile("s_waitcnt lgkmcnt(0)" ::: "memory"); SBAR();
    od = __builtin_amdgcn_mfma_f32_32x32x16_bf16(pa0, PKF(l0, h0), od, 0, 0, 0);
    od = __builtin_amdgcn_mfma_f32_32x32x16_bf16(pa1, PKF(l1, h1), od, 0, 0, 0);
    od = __builtin_amdgcn_mfma_f32_32x32x16_bf16(pa2, PKF(l2, h2), od, 0, 0, 0);
    od = __builtin_amdgcn_mfma_f32_32x32x16_bf16(pa3, PKF(l3, h3), od, 0, 0, 0);
}
template <int D0, int KS> __device__ __forceinline__ void pv_step(f32x16& od, unsigned vb, bf16x8 pa) {
    const s16x4 l0 = tr_read<v_rd_off(D0, KS, 0)>(vb), h0 = tr_read<v_rd_off(D0, KS, 1)>(vb);
    asm volatile("s_waitcnt lgkmcnt(0)" ::: "memory"); SBAR();
    od = __builtin_amdgcn_mfma_f32_32x32x16_bf16(pa, PKF(l0, h0), od, 0, 0, 0);
}

constexpr float ATT_THRL = 11.5f;

__device__ __forceinline__ void attn_unit(LAS unsigned char* lds, LAS unsigned char* ldc, const bf16_t* Qb, const bf16_t* Kb, const bf16_t* Vb, fp8_t* Ycat, const float* relb, int b, int h, int qb, int wv) {
    int tid = TIDX(wv); asm volatile("" : "+v"(tid));
    const int wid = __builtin_amdgcn_readfirstlane(tid >> 6), lane = tid & 63, r32 = lane & 31, hi = lane >> 5;
    LAS unsigned char* V_lds = lds; LAS unsigned char* K_lds = lds + 65536;
    LAS float* tb = (LAS float*)(ldc + LC_PARK);
    LAS float* wsf = (LAS float*)(ldc + LC_PARK + 2048) + wid * 64; LAS float* li_l = wsf; LAS float* al_l = wsf + 32;
    __syncthreads();
    for (int i = tid; i < NREL; i += 512) tb[i] = relb[i] * LOG2E;
    const int seqrow0 = b * SEQ, c0 = 4 * qb, t0 = c0 >= 8 ? c0 - 8 : 0, jend = c0 + 3, cw = c0 + (wid >> 1), nms = (jend - t0 + 1) >> 1;
    float m_reg = -1e30f, l_reg = 0.f; f32x16 o[4];
#pragma unroll
    for (int d = 0; d < 4; ++d)
#pragma unroll
        for (int r = 0; r < 16; ++r) o[d][r] = 0.f;
    bf16x8 qr[8];
    { const bf16_t* Qw = Qb + (size_t)(seqrow0 + qb * 256 + wid * 32 + r32) * AW + h * HD + hi * 8;
#pragma unroll
      for (int d0 = 0; d0 < 8; ++d0) qr[d0] = *(const bf16x8*)(Qw + d0 * 16); }
    const int sr = tid >> 4, sc = (tid & 15) * 8, vst0 = v_st(sr, sc), vst1 = v_st(32 + sr, sc);
    const unsigned vb0 = (unsigned)(size_t)V_lds + (unsigned)v_rd_base(lane);
    bf16x8 ks0, ks1, vs0, vs1;
#define ASLOAD(jj) do { const size_t kr = (size_t)(seqrow0 + (jj) * 64 + sr) * AW + h * HD + sc; \
        ks0 = *(const bf16x8*)(Kb + kr); ks1 = *(const bf16x8*)(Kb + kr + 32 * AW); vs0 = *(const bf16x8*)(Vb + kr); vs1 = *(const bf16x8*)(Vb + kr + 32 * AW); } while (0)
#define ASWRITE(ts) do { *(LAS bf16x8*)(V_lds + (ts) * 16384 + vst0) = vs0; *(LAS bf16x8*)(V_lds + (ts) * 16384 + vst1) = vs1; \
        *(LAS bf16x8*)(K_lds + (ts) * 16384 + KSWZ(sr, sc * 2)) = ks0; *(LAS bf16x8*)(K_lds + (ts) * 16384 + KSWZ(32 + sr, sc * 2)) = ks1; } while (0)
#define PK4(P, BASE, OUT) do { unsigned a0 = cvt_pk_bf16(P[BASE + 0], P[BASE + 1]), a1 = cvt_pk_bf16(P[BASE + 2], P[BASE + 3]);   \
    unsigned b0 = cvt_pk_bf16(P[BASE + 4], P[BASE + 5]), b1 = cvt_pk_bf16(P[BASE + 6], P[BASE + 7]);                              \
    auto r0 = __builtin_amdgcn_permlane32_swap(a0, b0, false, false); auto r1 = __builtin_amdgcn_permlane32_swap(a1, b1, false, false); \
    u32x4 w = {r0[0], r1[0], r0[1], r1[1]}; OUT = __builtin_bit_cast(bf16x8, w); } while (0)
#define ATT_TILE(j, ts) do { if ((j) >= cw - 8 && (j) <= cw) { \
            f32x16 p0, p1; \
            _Pragma("unroll") for (int r = 0; r < 16; ++r) { p0[r] = 0.f; p1[r] = 0.f; } \
            const LAS unsigned char* Ks = K_lds + (ts) * 16384; \
            _Pragma("unroll") for (int d0 = 0; d0 < 8; ++d0) { const int cb = (d0 * 16 + hi * 8) * 2; \
                const bf16x8 b0 = *(const LAS bf16x8*)(Ks + KSWZ(r32, cb)); \
                const bf16x8 b1 = *(const LAS bf16x8*)(Ks + KSWZ(32 + r32, cb)); \
                p0 = __builtin_amdgcn_mfma_f32_32x32x16_bf16(b0, qr[d0], p0, 0, 0, 0); \
                p1 = __builtin_amdgcn_mfma_f32_32x32x16_bf16(b1, qr[d0], p1, 0, 0, 0); } \
            const int dj = cw - (j); \
            if (dj >= 3) { const float cbias = tb[256]; \
                _Pragma("unroll") for (int r = 0; r < 16; ++r) { p0[r] += cbias; p1[r] += cbias; } } \
            else { const int bb = 64 * dj + 32 * (wid & 1) + r32 + 128; \
                _Pragma("unroll") for (int r = 0; r < 16; ++r) { const int i0 = bb - crow(r, hi), i1 = i0 - 32; p0[r] += tb[i0 > 256 ? 256 : i0]; p1[r] += tb[i1 > 256 ? 256 : i1]; } } \
            float pmax = p0[0]; \
            _Pragma("unroll") for (int r = 1; r < 16; ++r) pmax = fmaxf(pmax, p0[r]); \
            _Pragma("unroll") for (int r = 0; r < 16; ++r) pmax = fmaxf(pmax, p1[r]); \
            { auto rr = __builtin_amdgcn_permlane32_swap(__float_as_uint(pmax), __float_as_uint(pmax), false, false); \
              pmax = fmaxf(__uint_as_float(rr[0]), __uint_as_float(rr[1])); } \
            float mn, alpha; \
            if (__all(pmax - m_reg <= ATT_THRL)) { mn = m_reg; alpha = 1.f; } \
            else { mn = fmaxf(m_reg, pmax); alpha = __builtin_amdgcn_exp2f(m_reg - mn); m_reg = mn; } \
            float ps = 0.f; \
            _Pragma("unroll") for (int r = 0; r < 16; ++r) { p0[r] = __builtin_amdgcn_exp2f(p0[r] - mn); p1[r] = __builtin_amdgcn_exp2f(p1[r] - mn); ps += p0[r] + p1[r]; } \
            { auto rr = __builtin_amdgcn_permlane32_swap(__float_as_uint(ps), __float_as_uint(ps), false, false); \
              ps = __uint_as_float(rr[0]) + __uint_as_float(rr[1]); } \
            l_reg = l_reg * alpha + ps; \
            if (__any(alpha < 1.f)) { if (hi == 0) al_l[r32] = alpha; LDS_WAIT(); \
                _Pragma("unroll") for (int r = 0; r < 16; ++r) { const float a_ = al_l[crow(r, hi)]; \
                    _Pragma("unroll") for (int d = 0; d < 4; ++d) o[d][r] *= a_; } } \
            bf16x8 pa0, pa1, pa2, pa3; \
            PK4(p0, 0, pa0); PK4(p0, 8, pa1); PK4(p1, 0, pa2); PK4(p1, 8, pa3); \
            const unsigned vb = vb0 + (unsigned)(ts) * 16384u; \
            pv_one<0>(o[0], vb, pa0, pa1, pa2, pa3); pv_one<1>(o[1], vb, pa0, pa1, pa2, pa3); pv_one<2>(o[2], vb, pa0, pa1, pa2, pa3); pv_one<3>(o[3], vb, pa0, pa1, pa2, pa3); } } while (0)
    ASLOAD(t0); ASWRITE(0); ASLOAD(t0 + 1); ASWRITE(1); if (nms > 1) ASLOAD(t0 + 2);
    for (int ms = 0; ms < nms; ++ms) {
        const int buf = ms & 1, jA = t0 + 2 * ms; const bool more = ms + 1 < nms;
        __syncthreads();
        if (more) { ASWRITE((buf ^ 1) * 2); ASLOAD(jA + 3); }
        ATT_TILE(jA, buf * 2);
        if (more) { ASWRITE((buf ^ 1) * 2 + 1); if (ms + 2 < nms) ASLOAD(jA + 4); }
        ATT_TILE(jA + 1, buf * 2 + 1);
    }
#undef ATT_TILE
#undef PK4
#undef ASLOAD
#undef ASWRITE
    if (hi == 0) li_l[r32] = l_reg; LDS_WAIT();
    fp8_t* Ow = Ycat + (size_t)(seqrow0 + qb * 256 + wid * 32) * D + h * HD + r32;
#pragma unroll
    for (int r = 0; r < 16; ++r) { const int orow = crow(r, hi); const float rl = __builtin_amdgcn_rcpf(li_l[orow]) * SC_Y;
#pragma unroll
        for (int d0 = 0; d0 < 4; ++d0) Ow[(size_t)orow * D + d0 * 32] = f2fp8(o[d0][r] * rl); }
}

__device__ __forceinline__ void sgu_unit2(LAS unsigned char* lds, LAS unsigned char* ldc, const bf16_t* Ub, const bf16_t* Vsb, const float* vstat, const float* lng, const float* lnb,
                                          const float* Wl, const float* bl, fp8_t* Ycat, int u0, int u1, int wv) {
    int tid = TIDX(wv); asm volatile("" : "+v"(tid));
    const int wid = __builtin_amdgcn_readfirstlane(tid >> 6), lane = tid & 63, r32 = lane & 31, hi = lane >> 5;
    const int half = wid >> 2, rb = wid & 3, htid = tid & 255;
    const int u = half ? u1 : u0; const int g = u & 7, nb = (u >> 3) & 15, b = u >> 7;
    const float* Wg = Wl + (size_t)g * 128 * 128; const float* bsg = bl + g * 128;
    LAS f32x2* st = (LAS f32x2*)(ldc + LC_SGUST) + half * 128;
    LAS unsigned char* tile = lds + half * 32768;
    const int row0 = b * SEQ + nb * 128;
    const int t = 32 * rb + r32;
    const int sr = htid >> 4, sc = (htid & 15) * 8;
    f32x2 sp[16];
    if (htid < 128) { const f32x2* p = (const f32x2*)(vstat + (size_t)(row0 + htid) * 32);
#pragma unroll
        for (int i = 0; i < 16; ++i) sp[i] = p[i]; }
    bf16x8 xv[8];
#pragma unroll
    for (int k = 0; k < 8; ++k) xv[k] = *(const bf16x8*)(Vsb + (size_t)(row0 + sr + 16 * k) * SW + g * 128 + sc);
    const f32x4 g0 = *(const f32x4*)(lng + g * 128 + sc), g1 = *(const f32x4*)(lng + g * 128 + sc + 4), b0 = *(const f32x4*)(lnb + g * 128 + sc), b1 = *(const f32x4*)(lnb + g * 128 + sc + 4);
    const float* wrow = Wg + (size_t)t * 128 + 8 * hi;
    f32x4 wf[8][2];
#pragma unroll
    for (int ks = 0; ks < 8; ++ks) { wf[ks][0] = *(const f32x4*)(wrow + 16 * ks); wf[ks][1] = *(const f32x4*)(wrow + 16 * ks + 4); }
    __syncthreads();
    if (htid < 128) { float s1 = 0.f, s2 = 0.f;
#pragma unroll
        for (int i = 0; i < 16; ++i) { s1 += sp[i].x; s2 += sp[i].y; }
        const float mean = s1 * (1.f / SW); float var = s2 * (1.f / SW) - mean * mean; var = var > 0.f ? var : 0.f;
        st[htid] = (f32x2){mean, 1.0f / sqrtf(var + LN_EPS)}; }
    __syncthreads();
#pragma unroll
    for (int k = 0; k < 8; ++k) { const int row = sr + 16 * k; const bf16x8 x = xv[k]; const f32x2 ms = st[row];
        float y[8];
#pragma unroll
        for (int i = 0; i < 4; ++i) { y[i] = (bf2f((unsigned short)x[i]) - ms.x) * ms.y * g0[i] + b0[i]; y[4 + i] = (bf2f((unsigned short)x[4 + i]) - ms.x) * ms.y * g1[i] + b1[i]; }
        u32x4 w; w.x = cvt_pk_bf16(y[0], y[1]); w.y = cvt_pk_bf16(y[2], y[3]); w.z = cvt_pk_bf16(y[4], y[5]); w.w = cvt_pk_bf16(y[6], y[7]);
        *(LAS u32x4*)(tile + (row >> 6) * 16384 + v_st(row & 63, sc)) = w; }
    unsigned short uu[16][4]; float bsv[16];
#pragma unroll
    for (int r = 0; r < 16; ++r) { const int tt = 32 * rb + crow(r, hi); bsv[r] = bsg[tt];
#pragma unroll
        for (int d = 0; d < 4; ++d) uu[r][d] = Ub[(size_t)(row0 + tt) * SW + g * 128 + 32 * d + r32]; }
    __syncthreads();
    f32x16 o[4];
#pragma unroll
    for (int d = 0; d < 4; ++d)
#pragma unroll
        for (int r = 0; r < 16; ++r) o[d][r] = 0.f;
    const unsigned vb0 = (unsigned)(size_t)tile + (unsigned)v_rd_base(lane);
#define SGU_STEP(KS) do { if ((KS) <= 2 * rb + 1) { const int s0 = 16 * (KS) + 8 * hi; const f32x4 wa = wf[KS][0], wb = wf[KS][1]; \
        float wv[8] = {wa[0], wa[1], wa[2], wa[3], wb[0], wb[1], wb[2], wb[3]}; \
        _Pragma("unroll") for (int i = 0; i < 8; ++i) wv[i] = (s0 + i <= t) ? wv[i] : 0.f; \
        u32x4 w; w.x = cvt_pk_bf16(wv[0], wv[1]); w.y = cvt_pk_bf16(wv[2], wv[3]); w.z = cvt_pk_bf16(wv[4], wv[5]); w.w = cvt_pk_bf16(wv[6], wv[7]); \
        const bf16x8 pa = __builtin_bit_cast(bf16x8, w); const unsigned vb = vb0 + (unsigned)(((KS) >> 2) * 16384); \
        pv_step<0, (KS) & 3>(o[0], vb, pa); pv_step<1, (KS) & 3>(o[1], vb, pa); pv_step<2, (KS) & 3>(o[2], vb, pa); pv_step<3, (KS) & 3>(o[3], vb, pa); } } while (0)
    SGU_STEP(0); SGU_STEP(1); SGU_STEP(2); SGU_STEP(3); SGU_STEP(4); SGU_STEP(5); SGU_STEP(6); SGU_STEP(7);
#undef SGU_STEP
#pragma unroll
    for (int r = 0; r < 16; ++r) { const int tt = 32 * rb + crow(r, hi); const size_t row = (size_t)(row0 + tt);
#pragma unroll
        for (int d = 0; d < 4; ++d) Ycat[row * D + AW + g * 128 + 32 * d + r32] = f2fp8(bf2f(uu[r][d]) * (o[d][r] + bsv[r]) * SC_Y); }
}

#ifndef PH_MASK
#define PH_MASK 0x1ff
#endif
#define PH(k) ((PH_MASK >> (k)) & 1)
#ifndef MOE_SPLIT
#define MOE_SPLIT(l) ((l) == DEPTH - 1 ? 1 : 0)
#endif
#ifndef REP_MASK
#define REP_MASK 0
#endif
#define NREP(k) (((REP_MASK >> (k)) & 1) ? 2 : 1)
struct Args { const float* in[19]; float* out; unsigned char* ws; };
enum { I_X = 0, I_LNG, I_LNB, I_WIN, I_REL, I_SLNG, I_SLNB, I_SW, I_SB, I_WOUT, I_L1G, I_L1B, I_RW, I_RB, I_WG, I_WU, I_WD, I_L2G, I_L2B };

struct TItem { const float* src; void* dst; int N, Kd, q8; };
__device__ __forceinline__ void titem_load(const TItem& t, int lane, f32x4 (&v)[16]) {
    const float* p = t.src + (size_t)(16 * (lane >> 3)) * t.N + 4 * (lane & 7);
#pragma unroll
    for (int i = 0; i < 16; ++i) v[i] = __builtin_nontemporal_load((const f32x4*)(p + (size_t)i * t.N));
}
__device__ __forceinline__ void titem_store(const TItem& t, int lane, const f32x4 (&v)[16]) {
    if (t.q8) { fp8_t* q = (fp8_t*)t.dst + (size_t)(4 * (lane & 7)) * t.Kd + 16 * (lane >> 3);
#pragma unroll
        for (int c = 0; c < 4; ++c) { u32x4 o; o.x = pk4_fp8(v[0][c] * SC_W, v[1][c] * SC_W, v[2][c] * SC_W, v[3][c] * SC_W); o.y = pk4_fp8(v[4][c] * SC_W, v[5][c] * SC_W, v[6][c] * SC_W, v[7][c] * SC_W);
            o.z = pk4_fp8(v[8][c] * SC_W, v[9][c] * SC_W, v[10][c] * SC_W, v[11][c] * SC_W); o.w = pk4_fp8(v[12][c] * SC_W, v[13][c] * SC_W, v[14][c] * SC_W, v[15][c] * SC_W);
            __builtin_nontemporal_store(o, (u32x4*)(q + (size_t)c * t.Kd)); }
    } else { bf16_t* q = (bf16_t*)t.dst + (size_t)(4 * (lane & 7)) * t.Kd + 16 * (lane >> 3);
#pragma unroll
        for (int c = 0; c < 4; ++c) { u32x4 o0, o1; o0.x = cvt_pk_bf16(v[0][c], v[1][c]); o0.y = cvt_pk_bf16(v[2][c], v[3][c]); o0.z = cvt_pk_bf16(v[4][c], v[5][c]); o0.w = cvt_pk_bf16(v[6][c], v[7][c]);
            o1.x = cvt_pk_bf16(v[8][c], v[9][c]); o1.y = cvt_pk_bf16(v[10][c], v[11][c]); o1.z = cvt_pk_bf16(v[12][c], v[13][c]); o1.w = cvt_pk_bf16(v[14][c], v[15][c]);
            __builtin_nontemporal_store(o0, (u32x4*)(q + (size_t)c * t.Kd)); __builtin_nontemporal_store(o1, (u32x4*)(q + (size_t)c * t.Kd + 8)); }
    }
}
constexpr int CV_IN = 16 * 160, CV_OUT = 16 * 64, CV_E = 512, CV_LAYER = CV_IN + CV_OUT + NE * 3 * CV_E, CV_TOTAL = DEPTH * CV_LAYER;
__device__ __forceinline__ TItem titem_decode(int it, const float* w_in, const float* w_out, const float* w_g, const float* w_u, const float* w_d, fp8_t* WinQ, bf16_t* WoutT, fp8_t* WguQ, fp8_t* WdQ) {
    TItem t; const int l = it / CV_LAYER; int r = it - l * CV_LAYER;
    if (r < CV_IN) { const int kb = r / 160, nb = r % 160; t.q8 = 1; t.N = NIN; t.Kd = D; t.src = w_in + (size_t)l * D * NIN + (size_t)(128 * kb) * NIN + 32 * nb; t.dst = WinQ + (size_t)l * NIN * D + (size_t)(32 * nb) * D + 128 * kb; return t; }
    r -= CV_IN;
    if (r < CV_OUT) { const int kb = r / 64, nb = r % 64; t.q8 = 1; t.N = D; t.Kd = D; t.src = w_out + (size_t)l * D * D + (size_t)(128 * kb) * D + 32 * nb; t.dst = (fp8_t*)WoutT + (size_t)l * D * D + (size_t)(32 * nb) * D + 128 * kb; return t; }
    r -= CV_OUT;
    const int e = r / (3 * CV_E), rr = r % (3 * CV_E), which = rr / CV_E, idx = rr % CV_E; const size_t le = (size_t)l * NE + e; t.q8 = 1;
    if (which < 2) { const int kb = idx / 32, nb = idx % 32, n0 = 32 * nb;
        t.N = FF; t.Kd = D; t.src = (which == 0 ? w_g : w_u) + le * D * FF + (size_t)(128 * kb) * FF + n0; t.dst = WguQ + le * (size_t)(2 * FF) * D + (size_t)((n0 >> 7) * 256 + which * 128 + (n0 & 127)) * D + 128 * kb; }
    else { const int kb = idx / 64, nb = idx % 64;
        t.N = D; t.Kd = FF; t.src = w_d + le * FF * D + (size_t)(128 * kb) * D + 32 * nb; t.dst = WdQ + le * (size_t)D * FF + (size_t)(32 * nb) * FF + 128 * kb; }
    return t;
}
constexpr int CV_AB = CV_IN + CV_OUT, CV_GU = NE * 2 * CV_E, CV_DN = NE * CV_E;
constexpr int CVQ_B = CV_AB, CVQ_C = CVQ_B + CV_GU, CVQ_D = CVQ_C + CV_DN, CVQ_E = CVQ_D + CV_AB, CVQ_F = CVQ_E + CV_GU;
static_assert(CVQ_D == CV_LAYER && CVQ_F + CV_DN == CV_TOTAL, "class layout");
#ifndef CV_S1
#define CV_S1 7000
#endif
#ifndef CV_S2
#define CV_S2 10000
#endif
#ifndef CV_S3
#define CV_S3 3000
#endif
#ifndef CV_X1
#define CV_X1 1280
#endif
#ifndef CV_X2
#define CV_X2 768
#endif
constexpr int CV_X = CV_X1 + CV_X2;
constexpr int CVP_1 = CVQ_C, CVP_0 = CVP_1 - CV_S1 - CV_X, CVP_2 = CVP_1 + CV_S2, CVP_3 = CVP_2 + CV_S3, CVP_4 = CVQ_F;
static_assert(CVP_0 >= CVQ_B && CVP_2 >= CVQ_D && CVP_3 >= CVQ_E && CVP_3 <= CVP_4, "conversion schedule: C inside the layer-0 gate/up tail, D done by the end of layer 0, E's rest fits the layer-1 in-proj tail");
__device__ __forceinline__ int cv_perm(int p) {
    if (p < CVQ_B) return p;
    if (p < CVQ_C) { const int k = p - CVQ_B; return CV_AB + (k / (2 * CV_E)) * (3 * CV_E) + (k % (2 * CV_E)); }
    if (p < CVQ_D) { const int k = p - CVQ_C; return CV_AB + (k / CV_E) * (3 * CV_E) + 2 * CV_E + (k % CV_E); }
    if (p < CVQ_E) return p;
    if (p < CVQ_F) { const int k = p - CVQ_E; return CV_LAYER + CV_AB + (k / (2 * CV_E)) * (3 * CV_E) + (k % (2 * CV_E)); }
    { const int k = p - CVQ_F; return CV_LAYER + CV_AB + (k / CV_E) * (3 * CV_E) + 2 * CV_E + (k % CV_E); }
}
__device__ __forceinline__ void titem_dma(const TItem& t, int lane, LAS unsigned char* slot) {
    const float* p = t.src + (size_t)(16 * (lane >> 3)) * t.N + 4 * (lane & 7);
#pragma unroll
    for (int i = 0; i < 16; ++i) __builtin_amdgcn_global_load_lds((const unsigned*)(p + (size_t)i * t.N), (LAS unsigned*)(slot + i * 1024), 16, 0,   2);
}
__device__ __forceinline__ void convert_range(int lo, int hi, int wr_, int nw, int lane, LAS unsigned char* lds, const float* w_in, const float* w_out, const float* w_g, const float* w_u, const float* w_d, fp8_t* WinQ, bf16_t* WoutT, fp8_t* WguQ, fp8_t* WdQ) {
#define CV_DEC(i) titem_decode(cv_perm(i), w_in, w_out, w_g, w_u, w_d, WinQ, WoutT, WguQ, WdQ)
    int itA = lo + wr_; if (itA >= hi) return;
    LAS unsigned char* slot = lds + (wr_ & 7) * 16384;
    const int itB = itA + nw; bool hB = itB < hi;
    TItem ta = CV_DEC(itA), tb = ta; f32x4 va[16], vb[16];
    titem_dma(ta, lane, slot); if (hB) { tb = CV_DEC(itB); titem_load(tb, lane, vb); }
    for (;;) {
        VM_WAIT();
#pragma unroll
        for (int i = 0; i < 16; ++i) va[i] = *(const LAS f32x4*)(slot + i * 1024 + lane * 16);
        LDS_WAIT();
        const int itC = itA + 2 * nw; const bool hC = itC < hi; TItem tc = ta; if (hC) { tc = CV_DEC(itC); titem_dma(tc, lane, slot); }
        if (hB) titem_store(tb, lane, vb);
        const int itD = itC + nw; const bool hD = hC && itD < hi; TItem td = tb; if (hD) { td = CV_DEC(itD); titem_load(td, lane, vb); }
        titem_store(ta, lane, va);
        if (!hC) break;
        ta = tc; tb = td; hB = hD; itA = itC;
    }
#undef CV_DEC
}

template <bool FENCE = false, bool WF32 = false, bool WBF = true, bool WLDS = false, bool WQ = false> __device__ __forceinline__ void ln_row(f32x4 (&v)[8], const float* g, const float* b, int lane, float* outf, bf16_t* outb, LAS unsigned char* img = nullptr, int rl = 0, fp8_t* outq = nullptr) {
    asm volatile("" : "+s"(g), "+s"(b));
    float s = 0.f;
#pragma unroll
    for (int j = 0; j < 8; ++j) s += (v[j][0] + v[j][1]) + (v[j][2] + v[j][3]);
    const float mean = wave_sum(s) * (1.f / D); float s2 = 0.f;
#pragma unroll
    for (int j = 0; j < 8; ++j) { v[j] = v[j] - mean; s2 += (v[j][0] * v[j][0] + v[j][1] * v[j][1]) + (v[j][2] * v[j][2] + v[j][3] * v[j][3]); }
    const float rstd = 1.0f / sqrtf(wave_sum(s2) * (1.f / D) + LN_EPS);
#pragma unroll
    for (int j = 0; j < 8; ++j) { const f32x4 gg = *(const f32x4*)(g + 256 * j + 4 * lane), bb = *(const f32x4*)(b + 256 * j + 4 * lane);
        v[j] = v[j] * rstd * gg + bb;
        if (WF32) *(f32x4*)(outf + 256 * j + 4 * lane) = v[j];
        if (WQ) *(unsigned*)(outq + 256 * j + 4 * lane) = pk4_fp8(v[j][0], v[j][1], v[j][2], v[j][3]);
        if (WBF) { u32x2 w; w.x = cvt_pk_bf16(v[j][0], v[j][1]); w.y = cvt_pk_bf16(v[j][2], v[j][3]);
            *(u32x2*)(outb + 256 * j + 4 * lane) = w;
            if (WLDS) *(LAS u32x2*)(img + rl * 4096 + (((32 * j + (lane >> 1)) ^ rl) << 4) + (lane & 1) * 8) = w; }
        if (FENCE && (j & 1)) asm volatile("" ::: "memory"); }
}

__device__ __forceinline__ void route16(const float (&lg)[16], int& e1, int& e2, float& g1, float& g2) {
    float mx = lg[0];
#pragma unroll
    for (int e = 1; e < 16; ++e) mx = fmaxf(mx, lg[e]);
    float p[16];
#pragma unroll
    for (int e = 0; e < 16; ++e) p[e] = __builtin_amdgcn_exp2f((lg[e] - mx) * LOG2E);
    int bg = 0; float bs = -1.f;
#pragma unroll
    for (int g = 0; g < 4; ++g) { const float a = p[4 * g], b = p[4 * g + 1], c = p[4 * g + 2], d = p[4 * g + 3];
        const float h1 = fmaxf(a, b), l1 = fminf(a, b), h2 = fmaxf(c, d), l2 = fminf(c, d);
        const float s = fmaxf(h1, h2) + fmaxf(fminf(h1, h2), fmaxf(l1, l2));
        if (s > bs) { bs = s; bg = g; } }
    float q[4] = {p[0], p[1], p[2], p[3]};
#pragma unroll
    for (int g = 1; g < 4; ++g)
#pragma unroll
        for (int k = 0; k < 4; ++k) q[k] = (bg == g) ? p[4 * g + k] : q[k];
    int i1 = 0; float v1 = q[0];
#pragma unroll
    for (int k = 1; k < 4; ++k) if (q[k] > v1) { v1 = q[k]; i1 = k; }
    int i2 = 0; float v2 = -1.f;
#pragma unroll
    for (int k = 0; k < 4; ++k) if (k != i1 && q[k] > v2) { v2 = q[k]; i2 = k; }
    e1 = 4 * bg + i1; e2 = 4 * bg + i2; const float inv = 1.0f / (v1 + v2); g1 = v1 * inv; g2 = v2 * inv;
}

__global__ void __launch_bounds__(512, 2) fwd(Args a) {
    extern __shared__ __attribute__((aligned(16))) unsigned char lds_raw[];
    LAS unsigned char* lds = (LAS unsigned char*)lds_raw;
    LAS unsigned char* ldc = lds + LC_OFF;
    const int wave = __builtin_amdgcn_readfirstlane((int)threadIdx.x >> 6); const int lane = lane_id(), tid = wave * 64 + lane;
    const int G = gridDim.x; const int bx = blockIdx.x; const int vcu = (G % 8 == 0) ? (bx % 8) * (G / 8) + bx / 8 : bx;
    unsigned char* ws = a.ws;
    unsigned* ctl = (unsigned*)(ws + WS_CTL);
    for (int u = tid; u < (LDS_BYTES - LC_OFF) / 4; u += 512) ((LAS unsigned*)ldc)[u] = 0u;
    __syncthreads();
    XcdBarrier bar = xcd_barrier_post(ctl + CW_BAR, (volatile LAS unsigned*)(ldc + LC_XB), wave);

    fp8_t* WinQ = (fp8_t*)(ws + WS_WIN); bf16_t* WoutT = (bf16_t*)(ws + WS_WOUT); fp8_t* WguQ = (fp8_t*)(ws + WS_WGU); fp8_t* WdQ = (fp8_t*)(ws + WS_WD);
    bf16_t* Hb = (bf16_t*)(ws + WS_HB); bf16_t* Qb = (bf16_t*)(ws + WS_Q); bf16_t* Kb = Qb + (size_t)M * 1024; bf16_t* Vb = Kb + (size_t)M * 1024; bf16_t* Ub = Vb + (size_t)M * 1024; bf16_t* Vsb = Ub + (size_t)M * 1024;
    fp8_t* Ycat = (fp8_t*)(ws + WS_YCAT); float* vstat = (float*)(ws + WS_STAT);
    int* tok_e = (int*)(ws + WS_ROUTE); int* tok_pos = tok_e + 2 * M; float* tok_gate = (float*)(tok_pos + 2 * M); int* elist = (int*)(tok_gate + 2 * M); bf16_t* RwT = (bf16_t*)(elist + NE * M);
    fp8_t* Ybuf = (fp8_t*)(ws + WS_Y);
    fp8_t* Hq = (fp8_t*)(ws + WS_HQ); fp8_t* HidQ = (fp8_t*)(ws + WS_HID);
    float* Hf = a.out;
    const int gw = vcu * 8 + wave, NGW = G * 8;

    if (PH(0)) for (int rep_ = 0; rep_ < NREP(0); ++rep_) {
#define CONVERT(lo, hi, rank, nw) convert_range(lo, hi, rank, nw, lane, lds, a.in[I_WIN], a.in[I_WOUT], a.in[I_WG], a.in[I_WU], a.in[I_WD], WinQ, WoutT, WguQ, WdQ)
        CONVERT(0, CVP_0, gw, NGW);
        for (int i = (vcu * 8 + wave) * 64 + lane; i < NE * D; i += NGW * 64) { const int e = i / D, k = i % D; RwT[i] = (bf16_t)(cvt_pk_bf16(a.in[I_RW][(size_t)k * NE + e], 0.f) & 0xffffu); }
        {
#define LD_X(v, m) do { const float* xr_ = a.in[I_X] + (size_t)(m) * D; _Pragma("unroll") for (int j = 0; j < 8; ++j) v[j] = __builtin_nontemporal_load((const f32x4*)(xr_ + 256 * j + 4 * lane)); } while (0)
            f32x4 va[8], vb[8]; int m = gw; if (m < M) LD_X(va, m);
            for (; m < M; m += 2 * NGW) { const int m2 = m + NGW, m3 = m2 + NGW;
                if (m2 < M) LD_X(vb, m2);
                ln_row<false, false, true, false, true>(va, a.in[I_LNG], a.in[I_LNB], lane, nullptr, Hb + (size_t)m * D, nullptr, 0, Hq + (size_t)m * D);
                if (m3 < M) LD_X(va, m3);
                if (m2 < M) ln_row<false, false, true, false, true>(vb, a.in[I_LNG], a.in[I_LNB], lane, nullptr, Hb + (size_t)m2 * D, nullptr, 0, Hq + (size_t)m2 * D); }
#undef LD_X
        }
    }
    xcd_barrier(bar);

    for (int l = 0; l < DEPTH; ++l) {
        if (PH(1)) for (int rep_ = 0; rep_ < NREP(1); ++rep_) { pg8::Gemm g{(const bf16_t*)Hq, (const bf16_t*)(WinQ + (size_t)l * NIN * D), D}; pg8::DenseOrder S{M / 256, NIN / 256, G, bx, D}; pg8::EpiIn E{Qb, vstat, 1.0f / SC_W};
          pg8::gemm_phase<pg8::EpiIn, pg8::DenseOrder, true>(lds, ldc + LC_PARK, g, S, E, wave);
          { constexpr int U = (M / 256) * (NIN / 256); const int busy = U % G;
            if (bx >= busy) { int ln2 = lane_id(); asm volatile("" : "+v"(ln2)); const int lane = ln2 & 63; const int rk = (bx - busy) * 8 + wave, nw = (G - busy) * 8;
                if (l == 0) CONVERT(CVP_0, CVP_1 - CV_X, rk, nw); else CONVERT(CVP_3, CVP_4 - CV_X, rk, nw); } } }
        xcd_barrier(bar);
        if (PH(2)) for (int rep_ = 0; rep_ < NREP(2); ++rep_) for (int u = vcu; u < NBATCH * NH * 8; u += G) { const int qb = u & 7, h = (u >> 3) & 7, b = u >> 6;
            attn_unit(lds, ldc, Qb, Kb, Vb, Ycat, a.in[I_REL] + ((size_t)l * NH + h) * NREL, b, h, qb, wave); }
        if (PH(3)) for (int rep_ = 0; rep_ < NREP(3); ++rep_) for (int u = vcu; u < NBATCH * 16 * NG; u += 2 * G) { const int u1 = u + G < NBATCH * 16 * NG ? u + G : u;
            sgu_unit2(lds, ldc, Ub, Vsb, vstat, a.in[I_SLNG] + (size_t)l * SW, a.in[I_SLNB] + (size_t)l * SW, a.in[I_SW] + (size_t)l * NG * 128 * 128, a.in[I_SB] + (size_t)l * NG * 128, Ycat, u, u1, wave); }
        if ((vcu & 7) < 2) {
            __syncthreads();
            int ln2 = lane_id(); asm volatile("" : "+v"(ln2)); const int lane = ln2 & 63; const int rk = (vcu >> 3) * 8 + wave, nw = ((G + 7 - (vcu & 7)) >> 3) * 8, hiP = l == 0 ? CVP_1 : CVP_4;
            if ((vcu & 7) == 0) CONVERT(hiP - CV_X, hiP - CV_X2, rk, nw); else CONVERT(hiP - CV_X2, hiP, rk, nw); }
        xcd_barrier(bar);
        if (PH(4)) { pg8::Gemm g{(const bf16_t*)Ycat, (const bf16_t*)((const fp8_t*)WoutT + (size_t)l * D * D), D}; pg8::DenseOrder S{M / 256, D / 256, G, bx, D}; pg8::EpiOut E{Hb, 1.0f / (SC_W * SC_Y)};
          pg8::gemm_phase<pg8::EpiOut, pg8::DenseOrder, true>(lds, ldc + LC_PARK, g, S, E, wave); }
        xcd_barrier(bar);
        if (PH(5)) {
            int tid = TIDX(wave); asm volatile("" : "+v"(tid)); const int lane = tid & 63, r32 = lane & 31, hi = lane >> 5;
            LAS int* lcnt = (LAS int*)(ldc + LC_LCNT); LAS int* lbase = (LAS int*)(ldc + LC_LBASE);
            unsigned* gcnt = ctl + CW_CNT + 64 * l;
            const float* l1g = a.in[I_L1G] + (size_t)l * D; const float* l1b = a.in[I_L1B] + (size_t)l * D;
            for (int rb0 = vcu * 32; rb0 < M; rb0 += G * 32) {
                if (tid < 16) lcnt[tid] = 0;
                bf16x8 bw[16];
#pragma unroll
                for (int s_ = 0; s_ < 16; ++s_) { bw[s_] = (bf16x8){0, 0, 0, 0, 0, 0, 0, 0}; if (r32 < 16) bw[s_] = *(const bf16x8*)(RwT + (size_t)r32 * D + 256 * wave + 16 * s_ + 8 * hi); }
#define LD_H(v, m) do { const bf16_t* hr_ = Hb + (size_t)(m) * D; _Pragma("unroll") for (int j = 0; j < 8; ++j) v[j] = bf4_to_f32(*(const u32x2*)(hr_ + 256 * j + 4 * lane)); } while (0)
                { const int mb = rb0 + wave * 4; f32x4 va[8], vb[8]; LD_H(va, mb);
#pragma unroll 1
                  for (int rp = 0; rp < 4; rp += 2) {
                    LD_H(vb, mb + rp + 1);
                    ln_row<false, false, true, true, true>(va, l1g, l1b, lane, nullptr, Hb + (size_t)(mb + rp) * D, lds, wave * 4 + rp, Hq + (size_t)(mb + rp) * D);
                    if (rp + 2 < 4) LD_H(va, mb + rp + 2);
                    ln_row<false, false, true, true, true>(vb, l1g, l1b, lane, nullptr, Hb + (size_t)(mb + rp + 1) * D, lds, wave * 4 + rp + 1, Hq + (size_t)(mb + rp + 1) * D); } }
#undef LD_H
                __syncthreads();
                f32x16 lg;
#pragma unroll
                for (int r = 0; r < 16; ++r) lg[r] = 0.f;
#pragma unroll
                for (int s_ = 0; s_ < 16; ++s_) { const bf16x8 af = *(const LAS bf16x8*)(lds + r32 * 4096 + (((32 * wave + 2 * s_ + hi) ^ r32) << 4));
                    lg = __builtin_amdgcn_mfma_f32_32x32x16_bf16(af, bw[s_], lg, 0, 0, 0); }
                __syncthreads();
                LAS float* part = (LAS float*)lds;
                if (r32 < 16) {
#pragma unroll
                    for (int r = 0; r < 16; ++r) part[(wave * 32 + crow(r, hi)) * 16 + r32] = lg[r]; }
                __syncthreads();
                int e1 = 0, e2 = 0, p1 = 0, p2 = 0; float g1 = 0.f, g2 = 0.f;
                if (tid < 32) { float a0[16];
#pragma unroll
                    for (int e = 0; e < 16; ++e) { float acc_ = a.in[I_RB][e];
#pragma unroll
                        for (int w = 0; w < 8; ++w) acc_ += part[(w * 32 + tid) * 16 + e];
                        a0[e] = acc_; }
                    route16(a0, e1, e2, g1, g2);
                    p1 = atomicAdd((int*)(lcnt + e1), 1); p2 = atomicAdd((int*)(lcnt + e2), 1); }
                __syncthreads();
                if (tid < 16) lbase[tid] = (int)__hip_atomic_fetch_add(gcnt + tid, (unsigned)lcnt[tid], __ATOMIC_RELAXED, __HIP_MEMORY_SCOPE_AGENT);
                __syncthreads();
                if (tid < 32) { const int m = rb0 + tid; p1 += lbase[e1]; p2 += lbase[e2];
                    tok_e[2 * m] = e1; tok_e[2 * m + 1] = e2; tok_pos[2 * m] = p1; tok_pos[2 * m + 1] = p2; tok_gate[2 * m] = g1; tok_gate[2 * m + 1] = g2;
                    elist[e1 * M + p1] = m; elist[e2 * M + p2] = m; }
                __syncthreads();
            }
        }
        xcd_barrier(bar);
        LAS int* ecnt = (LAS int*)(ldc + LC_ECNT); LAS int* tstart = (LAS int*)(ldc + LC_TSTART);
        { int tq = TIDX(wave); asm volatile("" : "+v"(tq));
        if (tq < 16) ecnt[tq] = (int)__hip_atomic_load(ctl + CW_CNT + 64 * l + tq, __ATOMIC_RELAXED, __HIP_MEMORY_SCOPE_AGENT);
        __syncthreads();
        if (tq == 0) { int acc = 0; for (int e = 0; e < NE; ++e) { tstart[e] = acc; acc += (ecnt[e] + 255) >> 8; } tstart[NE] = acc; }
        __syncthreads(); }
#if 0
        if (tid < 16) ecnt[tid] = (int)__hip_atomic_load(ctl + CW_CNT + 64 * l + tid, __ATOMIC_RELAXED, __HIP_MEMORY_SCOPE_AGENT);
        __syncthreads();
        if (tid == 0) { int acc = 0; for (int e = 0; e < NE; ++e) { tstart[e] = acc; acc += (ecnt[e] + 255) >> 8; } tstart[NE] = acc; }
        __syncthreads();
#endif
        const int T = tstart[NE];
        if (PH(6)) for (int rep_ = 0; rep_ < NREP(6); ++rep_) { pg8::Gemm g{(const bf16_t*)Hq, (const bf16_t*)(WguQ + (size_t)l * NE * (2 * FF) * D), D}; pg8::MoeOrder<true, true> S{T, 8, G, bx, D, 8, 0, tstart, ecnt, elist}; pg8::EpiGU E{HidQ};
          pg8::gemm_phase<pg8::EpiGU, pg8::MoeOrder<true, true>, true>(lds, ldc + LC_PARK, g, S, E, wave);
          { const int busy = (T * 8) % G; if (bx >= busy) { int ln2 = lane_id(); asm volatile("" : "+v"(ln2)); const int lane = ln2 & 63; const int rk = (bx - busy) * 8 + wave, nw = (G - busy) * 8;
              if (l == 0) CONVERT(CVP_1, CVP_2, rk, nw); else CONVERT(CVP_4, CV_TOTAL, rk, nw); } } }
        xcd_barrier(bar);
        if (PH(7)) for (int rep_ = 0; rep_ < NREP(7); ++rep_) { pg8::Gemm g{(const bf16_t*)HidQ, (const bf16_t*)(WdQ + (size_t)l * NE * D * FF), FF}; pg8::MoeOrder<false, true> S{T, 8, G, bx, FF, 8, MOE_SPLIT(l), tstart, ecnt, elist}; pg8::EpiDown E{Ybuf};
          pg8::gemm_phase<pg8::EpiDown, pg8::MoeOrder<false, true>, true>(lds, ldc + LC_PARK, g, S, E, wave);
          if (l == 0) { const int busy = (T * 8) % G; if (bx >= busy) { int ln2 = lane_id(); asm volatile("" : "+v"(ln2)); const int lane = ln2 & 63; CONVERT(CVP_2, CVP_3, (bx - busy) * 8 + wave, (G - busy) * 8); } } }
        xcd_barrier(bar);
        if (PH(8)) {
            int tid = TIDX(wave); asm volatile("" : "+v"(tid)); const int lane = tid & 63;
            const float* l2g = a.in[I_L2G] + (size_t)l * D; const float* l2b = a.in[I_L2B] + (size_t)l * D;
#define LD_R(v, ya, yb, m) do { const int e1_ = tok_e[2 * (m)], e2_ = tok_e[2 * (m) + 1]; const int s1_ = tstart[e1_] * 256 + tok_pos[2 * (m)], s2_ = tstart[e2_] * 256 + tok_pos[2 * (m) + 1]; \
                const bf16_t* hr_ = Hb + (size_t)(m) * D; const fp8_t* y1_ = Ybuf + (size_t)s1_ * D; const fp8_t* y2_ = Ybuf + (size_t)s2_ * D; \
                _Pragma("unroll") for (int j = 0; j < 8; ++j) { v[j] = bf4_to_f32(*(const u32x2*)(hr_ + 256 * j + 4 * lane)); ya[j] = *(const unsigned*)(y1_ + 256 * j + 4 * lane); yb[j] = *(const unsigned*)(y2_ + 256 * j + 4 * lane); } } while (0)
#define FIN_R(v, ya, yb, m) do { const float g1_ = tok_gate[2 * (m)] * (1.0f / pg8::SC_O), g2_ = tok_gate[2 * (m) + 1] * (1.0f / pg8::SC_O); \
                _Pragma("unroll") for (int j = 0; j < 8; ++j) { const f32x2 a0_ = __builtin_amdgcn_cvt_pk_f32_fp8((int)ya[j], false), a1_ = __builtin_amdgcn_cvt_pk_f32_fp8((int)ya[j], true), b0_ = __builtin_amdgcn_cvt_pk_f32_fp8((int)yb[j], false), b1_ = __builtin_amdgcn_cvt_pk_f32_fp8((int)yb[j], true); \
                    const f32x4 t_ = {g1_ * a0_.x + g2_ * b0_.x, g1_ * a0_.y + g2_ * b0_.y, g1_ * a1_.x + g2_ * b1_.x, g1_ * a1_.y + g2_ * b1_.y}; \
                    v[j] = v[j] * ALPHA + t_; } \
                if (l + 1 < DEPTH) ln_row<true, false, true, false, true>(v, l2g, l2b, lane, nullptr, Hb + (size_t)(m) * D, nullptr, 0, Hq + (size_t)(m) * D); else ln_row<true, true, false>(v, l2g, l2b, lane, Hf + (size_t)(m) * D, nullptr); } while (0)
            if (NGW * 4 == M) {
                f32x4 va[8], vb[8]; unsigned ya1[8], ya2[8], yb1[8], yb2[8]; const int m0 = gw, m1 = gw + NGW, m2 = gw + 2 * NGW, m3 = gw + 3 * NGW;
                LD_R(va, ya1, ya2, m0); LD_R(vb, yb1, yb2, m1); FIN_R(va, ya1, ya2, m0); LD_R(va, ya1, ya2, m2); FIN_R(vb, yb1, yb2, m1); LD_R(vb, yb1, yb2, m3); FIN_R(va, ya1, ya2, m2); FIN_R(vb, yb1, yb2, m3);
            } else {
#pragma unroll 1
                for (int m = gw; m < M; m += NGW) { f32x4 va[8]; unsigned ya1[8], ya2[8]; LD_R(va, ya1, ya2, m); FIN_R(va, ya1, ya2, m); } }
#undef LD_R
#undef FIN_R
        }
        if (l + 1 < DEPTH) xcd_barrier(bar);
    }
}

extern "C" void kernel_launch(void* const* d_in, const int* in_sizes, int n_in, void* d_out, int out_size, void* d_ws, size_t ws_size, hipStream_t stream) {
    static int grid = 0;
    if (grid == 0) {
        if (n_in != 19 || out_size != M * D || ws_size < WS_END) { fprintf(stderr, "kernel_launch: unexpected shapes (n_in %d out %d ws %zu)\n", n_in, out_size, ws_size); grid = -1; return; }
        int dev = 0, cus = 0, per_cu = 0;
        if (hipGetDevice(&dev) != hipSuccess || hipDeviceGetAttribute(&cus, hipDeviceAttributeMultiprocessorCount, dev) != hipSuccess) { grid = -1; return; }
        if (hipFuncSetAttribute((const void*)fwd, hipFuncAttributeMaxDynamicSharedMemorySize, LDS_BYTES) != hipSuccess) { fprintf(stderr, "kernel_launch: hipFuncSetAttribute failed\n"); grid = -1; return; }
        if (hipOccupancyMaxActiveBlocksPerMultiprocessor(&per_cu, (const void*)fwd, 512, LDS_BYTES) != hipSuccess || per_cu < 1) { fprintf(stderr, "kernel_launch: occupancy query says %d\n", per_cu); (void)hipGetLastError(); grid = -1; return; }
        grid = cus;
    }
    if (grid < 0) return;
    (void)in_sizes;
    if (hipMemsetAsync((char*)d_ws + WS_CTL, 0, CTL_ZERO_BYTES, stream) != hipSuccess) return;
    Args a{};
    for (int i = 0; i < 19; ++i) a.in[i] = (const float*)d_in[i];
    a.out = (float*)d_out; a.ws = (unsigned char*)d_ws;
    hipLaunchKernelGGL(fwd, dim3(grid), dim3(512), LDS_BYTES, stream, a);
}
```
